# Optimizing an MI355X kernel written in HIP

```python
import jax, jax.numpy as jnp
from jax import lax
import numpy as np

D_MODEL = 2048
BATCH = 1
SEQ = 16384
DEPTH = 1

D_MIX = D_MODEL
LRU_WIDTH = D_MIX // 2
SC_WIDTH = D_MIX - LRU_WIDTH
LRU_HEADS = 16
LRU_HEAD_DIM = LRU_WIDTH // LRU_HEADS
SC_GROUPS = 16
LRU_CONV_K = 4
LRU_CONV_PAD_LEFT = 2
SC_CONV_K = 3
SC_CONV_PAD_LEFT = 1
LRU_C = 8.0
PROJ_COLS = 2 * LRU_WIDTH + 4 * SC_WIDTH
DEEPNORM_ALPHA = (2.0 * DEPTH) ** 0.25
DEEPNORM_BETA = (8.0 * DEPTH) ** -0.25
LN_EPS = 1e-5
RMS_EPS = 1e-6

kernel_name = "hybrid_rglru_shortconv_deepnorm_encoder"


def depthwise_conv(u, w, b, pad_left):
    k_w = w.shape[0]
    s = u.shape[1]
    up = jnp.pad(u, ((0, 0), (pad_left, k_w - 1 - pad_left), (0, 0)))
    out = up[:, 0:s, :] * w[0]
    for k in range(1, k_w):
        out = out + up[:, k:k + s, :] * w[k]
    if b is not None:
        out = out + b
    return out


def block_diag_linear(u, w, b):
    bsz, s, _ = u.shape
    uh = u.reshape(bsz, s, LRU_HEADS, LRU_HEAD_DIM)
    y = jnp.einsum('bshi,hij->bshj', uh, w) + b
    return y.reshape(bsz, s, LRU_HEADS * LRU_HEAD_DIM)


def rg_lru(u, w_a, b_a, w_x, b_x, lam, reverse):
    u32 = u.astype(jnp.float32)
    r = jax.nn.sigmoid(block_diag_linear(u32, w_a.astype(jnp.float32), b_a.astype(jnp.float32)))
    i = jax.nn.sigmoid(block_diag_linear(u32, w_x.astype(jnp.float32), b_x.astype(jnp.float32)))
    log_a = -LRU_C * r * jax.nn.softplus(-lam.astype(jnp.float32))
    a = jnp.exp(log_a)
    mult = jnp.sqrt(-jnp.expm1(2.0 * log_a))
    bvals = mult * (i * u32)

    def combine(left, right):
        a_l, b_l = left
        a_r, b_r = right
        return a_l * a_r, a_r * b_l + b_r

    _, h = lax.associative_scan(combine, (a, bvals), reverse=reverse, axis=1)
    return h


def group_rmsnorm(y, g):
    y32 = y.astype(jnp.float32)
    ms = jnp.mean(y32 * y32, axis=-1, keepdims=True)
    return y32 * lax.rsqrt(ms + RMS_EPS) * g.astype(jnp.float32)


def layernorm(y, g, b):
    y32 = y.astype(jnp.float32)
    mu = jnp.mean(y32, axis=-1, keepdims=True)
    var = jnp.mean(jnp.square(y32 - mu), axis=-1, keepdims=True)
    return (y32 - mu) * lax.rsqrt(var + LN_EPS) * g.astype(jnp.float32) + b.astype(jnp.float32)


def setup_inputs(seed: int = 0) -> dict:
    key = jax.random.key(seed)
    ks = jax.random.split(key, 24)
    f32 = jnp.float32
    L = DEPTH

    def lam_init(k):
        ac = jax.random.uniform(k, (L, LRU_WIDTH), f32, 0.9, 0.999)
        a = ac ** (1.0 / LRU_C)
        return jnp.log(a) - jnp.log1p(-a)

    bd_scale = LRU_HEAD_DIM ** -0.5
    return {
        "x": jax.random.normal(ks[0], (BATCH, SEQ, D_MODEL), f32),
        "w_in": jax.random.normal(ks[1], (L, D_MODEL, PROJ_COLS), f32) * D_MODEL ** -0.5,
        "lru_conv_w": jax.random.normal(ks[2], (L, LRU_CONV_K, LRU_WIDTH), f32) * LRU_CONV_K ** -0.5,
        "lru_conv_b": jax.random.normal(ks[3], (L, LRU_WIDTH), f32) * 0.01,
        "lru_wa_f": jax.random.normal(ks[4], (L, LRU_HEADS, LRU_HEAD_DIM, LRU_HEAD_DIM), f32) * bd_scale,
        "lru_ba_f": jax.random.normal(ks[5], (L, LRU_HEADS, LRU_HEAD_DIM), f32) * 0.01,
        "lru_wx_f": jax.random.normal(ks[6], (L, LRU_HEADS, LRU_HEAD_DIM, LRU_HEAD_DIM), f32) * bd_scale,
        "lru_bx_f": jax.random.normal(ks[7], (L, LRU_HEADS, LRU_HEAD_DIM), f32) * 0.01,
        "lru_lam_f": lam_init(ks[8]),
        "lru_wa_b": jax.random.normal(ks[9], (L, LRU_HEADS, LRU_HEAD_DIM, LRU_HEAD_DIM), f32) * bd_scale,
        "lru_ba_b": jax.random.normal(ks[10], (L, LRU_HEADS, LRU_HEAD_DIM), f32) * 0.01,
        "lru_wx_b": jax.random.normal(ks[11], (L, LRU_HEADS, LRU_HEAD_DIM, LRU_HEAD_DIM), f32) * bd_scale,
        "lru_bx_b": jax.random.normal(ks[12], (L, LRU_HEADS, LRU_HEAD_DIM), f32) * 0.01,
        "lru_lam_b": lam_init(ks[13]),
        "sc_conv_w": jax.random.normal(ks[14], (L, SC_CONV_K, SC_WIDTH), f32) * SC_CONV_K ** -0.5,
        "lru_norm_g": 1.0 + 0.02 * jax.random.normal(ks[15], (L, LRU_WIDTH), f32),
        "sc_norm_g": 1.0 + 0.02 * jax.random.normal(ks[16], (L, SC_WIDTH), f32),
        "w_out": jax.random.normal(ks[17], (L, D_MIX, D_MODEL), f32) * (D_MIX ** -0.5) * DEEPNORM_BETA,
        "ln_g": 1.0 + 0.02 * jax.random.normal(ks[18], (L, D_MODEL), f32),
        "ln_b": 0.02 * jax.random.normal(ks[19], (L, D_MODEL), f32),
    }


def reference(x, w_in, lru_conv_w, lru_conv_b, lru_wa_f, lru_ba_f, lru_wx_f, lru_bx_f, lru_lam_f,
              lru_wa_b, lru_ba_b, lru_wx_b, lru_bx_b, lru_lam_b, sc_conv_w, lru_norm_g, sc_norm_g,
              w_out, ln_g, ln_b):
    dtype = x.dtype
    o1 = LRU_WIDTH
    o2 = o1 + LRU_WIDTH
    o3 = o2 + SC_WIDTH
    o4 = o3 + SC_WIDTH
    o5 = o4 + SC_WIDTH
    for l in range(DEPTH):
        proj = jnp.einsum('bsd,dc->bsc', x, w_in[l])
        lru_x = proj[..., :o1]
        lru_gate = proj[..., o1:o2]
        sc_b = proj[..., o2:o3]
        sc_c = proj[..., o3:o4]
        sc_h = proj[..., o4:o5]
        sc_gate = proj[..., o5:]

        u = depthwise_conv(lru_x, lru_conv_w[l], lru_conv_b[l], LRU_CONV_PAD_LEFT)
        h = (rg_lru(u, lru_wa_f[l], lru_ba_f[l], lru_wx_f[l], lru_bx_f[l], lru_lam_f[l], reverse=False)
             + rg_lru(u, lru_wa_b[l], lru_ba_b[l], lru_wx_b[l], lru_bx_b[l], lru_lam_b[l], reverse=True))
        y_lru = group_rmsnorm(h * jax.nn.silu(lru_gate.astype(jnp.float32)), lru_norm_g[l])

        v = depthwise_conv(sc_c * sc_h, sc_conv_w[l], None, SC_CONV_PAD_LEFT)
        y_sc = group_rmsnorm(sc_b * v * jax.nn.silu(sc_gate), sc_norm_g[l])

        y = jnp.concatenate([y_lru, y_sc], axis=-1).astype(dtype)
        mixed = jnp.einsum('bsc,cd->bsd', y, w_out[l])

        x = layernorm(DEEPNORM_ALPHA * x + mixed, ln_g[l], ln_b[l]).astype(dtype)
    return x
```

```cpp
#include <hip/hip_runtime.h>
#include <hip/hip_cooperative_groups.h>
#include <cstdio>
namespace cg = cooperative_groups;

#ifndef MK_LAUNCHES
#define MK_LAUNCHES 1
#endif

namespace pg8 {
#define PG8_LAS __attribute__((address_space(3)))
typedef unsigned short bf16_t;
typedef short bf16x8 __attribute__((ext_vector_type(8)));
typedef float f32x4 __attribute__((ext_vector_type(4)));
typedef unsigned u32x4 __attribute__((ext_vector_type(4)));
constexpr int BM = 256, BK = 64, HALF = 128, HTB = HALF * BK * 2  , STAGE_BYTES = 8 * HTB, NXCD = 8, WGM = 8;

__host__ __device__ __forceinline__ int lds_byte(int r, int c) { const int st = (r >> 4) * 2 + (c >> 5), rr = r & 15, cc = c & 31, ob = rr * 64 + cc * 2; return st * 1024 + (ob ^ (((ob >> 9) & 1) << 5)); }
__host__ __device__ __forceinline__ void stage_rc(int b, int& R, int& C) { const int st = b / 1024, sb = b % 1024, swz = sb ^ (((sb >> 9) & 1) << 5); R = (st >> 1) * 16 + swz / 64; C = (st & 1) * 32 + (swz % 64) / 2; }
__host__ __device__ __forceinline__ int perm32(int rho) { const int n = rho >> 4, i = rho & 15; return 8 * (i >> 2) + 4 * n + (i & 3); }

struct Unit { int pm, pn; };
struct Gemm { const bf16_t* A; const bf16_t* Bt; int M, N, K; };

struct StaticOrder {
    int nM, nN, nwg, G, c;
    __host__ __device__ void init(int M, int N, int G_, int c_) { nM = M / BM; nN = N / BM; nwg = nM * nN; G = G_; c = c_; }
    __host__ __device__ bool next(int i, Unit& u) const {
        const long L = (long)i * G + c; if (L >= nwg) return false;
        int wgid = (int)L; { const int q = nwg / NXCD, r = nwg % NXCD, xcd = wgid % NXCD, off = wgid / NXCD; wgid = (xcd < r ? xcd * (q + 1) : r * (q + 1) + (xcd - r) * q) + off; }
        const int nig = WGM * nN, gid = wgid / nig, fm = gid * WGM, gsz = (nM - fm) < WGM ? (nM - fm) : WGM;
        u.pm = fm + ((wgid % nig) % gsz); u.pn = (wgid % nig) / gsz; return true;
    }
    __device__ __forceinline__ void a_ready(const Unit&) const {}
    __device__ __forceinline__ void done(const Unit&) const {}
};
__device__ __forceinline__ unsigned cvt_pk_bf16(float lo, float hi) { unsigned r; asm volatile("v_cvt_pk_bf16_f32 %0, %1, %2" : "=v"(r) : "v"(lo), "v"(hi)); return r; }
typedef float f32x2 __attribute__((ext_vector_type(2)));
__device__ __forceinline__ f32x2 gelu_pk(f32x2 v) {
    const f32x2 av = __builtin_elementwise_abs(v), d = av * 0.2316418882f + 1.0f;
    f32x2 t; t.x = __builtin_amdgcn_rcpf(d.x); t.y = __builtin_amdgcn_rcpf(d.y);
    f32x2 q = t * 0.5307027145f + (-0.7265760135f); q = q * t + 0.7107068705f; q = q * t + (-0.142248368f); q = q * t + 0.127414796f; q = q * t;
    const f32x2 s = (v * v) * (-0.72134752044f);
    f32x2 e; e.x = __builtin_amdgcn_exp2f(s.x); e.y = __builtin_amdgcn_exp2f(s.y);
    const f32x2 m = v * (q * e), r = v - m;
    f32x2 o; o.x = v.x < 0.f ? m.x : r.x; o.y = v.y < 0.f ? m.y : r.y; return o;
}

struct EpiF32 {
    static constexpr bool PERM = false, AFTER_DRAIN = false;
    float* C; int ldc; const float* bias;
    __device__ __forceinline__ void operator()(const f32x4 (&acc)[2][2][4][2], const Unit& u, int wr, int wc, int fr, int fq) const {
        const int row0 = u.pm * BM + wr * 64 + fr, col0 = u.pn * BM + wc * 32 + 4 * fq;
        f32x4 bv[2][2];
#pragma unroll
        for (int bj = 0; bj < 2; ++bj)
#pragma unroll
            for (int n = 0; n < 2; ++n) bv[bj][n] = bias ? *(const f32x4*)(bias + col0 + bj * HALF + n * 16) : (f32x4){0.f, 0.f, 0.f, 0.f};
#pragma unroll
        for (int ai = 0; ai < 2; ++ai)
#pragma unroll
            for (int m = 0; m < 4; ++m) { float* rowp = C + (size_t)(row0 + ai * HALF + m * 16) * ldc + col0;
#pragma unroll
                for (int bj = 0; bj < 2; ++bj)
#pragma unroll
                    for (int n = 0; n < 2; ++n) *(f32x4*)(rowp + bj * HALF + n * 16) = acc[ai][bj][m][n] + bv[bj][n]; }
    }
};
template <int ACT  > struct EpiBf16 {
    static constexpr bool PERM = true, AFTER_DRAIN = false;
    bf16_t* O; int ldc; const float* bias; int split_cols; size_t split_stride;
    __device__ __forceinline__ void operator()(const f32x4 (&acc)[2][2][4][2], const Unit& u, int wr, int wc, int fr, int fq) const {
        const int row0 = u.pm * BM + wr * 64 + fr; int colt = u.pn * BM; bf16_t* base = O;
        if (split_cols) { const int t = colt / split_cols; base += (size_t)t * split_stride; colt -= t * split_cols; }
        const int col0 = colt + wc * 32 + 8 * fq, bcol0 = u.pn * BM + wc * 32 + 8 * fq;
        f32x4 bv[2][2];
#pragma unroll
        for (int bj = 0; bj < 2; ++bj)
#pragma unroll
            for (int n = 0; n < 2; ++n) bv[bj][n] = bias ? *(const f32x4*)(bias + bcol0 + bj * HALF + 4 * n) : (f32x4){0.f, 0.f, 0.f, 0.f};
#pragma unroll
        for (int ai = 0; ai < 2; ++ai)
#pragma unroll
            for (int m = 0; m < 4; ++m) { bf16_t* rowp = base + (size_t)(row0 + ai * HALF + m * 16) * ldc + col0;
#pragma unroll
                for (int bj = 0; bj < 2; ++bj) { f32x4 v0 = acc[ai][bj][m][0] + bv[bj][0], v1 = acc[ai][bj][m][1] + bv[bj][1];
                    if (ACT == 1) { f32x2 a = gelu_pk((f32x2){v0[0], v0[1]}), b = gelu_pk((f32x2){v0[2], v0[3]}), c = gelu_pk((f32x2){v1[0], v1[1]}), d = gelu_pk((f32x2){v1[2], v1[3]});
                        v0 = (f32x4){a.x, a.y, b.x, b.y}; v1 = (f32x4){c.x, c.y, d.x, d.y}; }
                    if (ACT == 2) {
#pragma unroll
                        for (int j = 0; j < 4; ++j) { v0[j] = 0.5f * v0[j] * (1.0f + erff(v0[j] * 0.70710678f)); v1[j] = 0.5f * v1[j] * (1.0f + erff(v1[j] * 0.70710678f)); } }
                    u32x4 w; w.x = cvt_pk_bf16(v0[0], v0[1]); w.y = cvt_pk_bf16(v0[2], v0[3]); w.z = cvt_pk_bf16(v1[0], v1[1]); w.w = cvt_pk_bf16(v1[2], v1[3]);
                    *(u32x4*)(rowp + bj * HALF) = w; } }
    }
};
struct EpiZ {
    static constexpr bool PERM = false, AFTER_DRAIN = false;
    float* Z; const float* X; float* stats; int ldc; float alpha;
    __device__ __forceinline__ void operator()(const f32x4 (&acc)[2][2][4][2], const Unit& u, int wr, int wc, int fr, int fq) const {
        const int row0 = u.pm * BM + wr * 64 + fr, col0 = u.pn * BM + wc * 32 + 4 * fq;
#pragma unroll
        for (int ai = 0; ai < 2; ++ai)
#pragma unroll
            for (int m = 0; m < 4; ++m) { const int row = row0 + ai * HALF + m * 16; const size_t off = (size_t)row * ldc + col0; float s = 0.f, q = 0.f;
#pragma unroll
                for (int bj = 0; bj < 2; ++bj)
#pragma unroll
                    for (int n = 0; n < 2; ++n) { const f32x4 xv = *(const f32x4*)(X + off + bj * HALF + n * 16); const f32x4 z = acc[ai][bj][m][n] + alpha * xv;
                        *(f32x4*)(Z + off + bj * HALF + n * 16) = z; s += (z[0] + z[1]) + (z[2] + z[3]); q += (z[0] * z[0] + z[1] * z[1]) + (z[2] * z[2] + z[3] * z[3]); }
                s += __shfl_xor(s, 16); s += __shfl_xor(s, 32); q += __shfl_xor(q, 16); q += __shfl_xor(q, 32);
                if (fq == 0) { typedef float f32x2 __attribute__((ext_vector_type(2))); *(f32x2*)(stats + ((size_t)row * 32 + u.pn * 4 + wc) * 2) = (f32x2){s, q}; }
                asm volatile("" ::: "memory"); }
    }
};

template <class Epi, class Sched, bool STAMP = false>
__device__ __forceinline__ void gemm_phase(PG8_LAS unsigned char* lds, const Gemm g, const Sched& S, const Epi& E, unsigned long long* stamps) {
    const int tid = threadIdx.x, wid = __builtin_amdgcn_readfirstlane(tid >> 6), lane = tid & 63, wr = wid >> 2, wc = wid & 3, fr = lane & 15, fq = lane >> 4;
    const int K = g.K, nt = K / BK;
    int ts_lo = 0, ts_hi = 0, nts = 0; const unsigned long long rt_entry = STAMP ? (unsigned long long)wall_clock64() : 0ull;
#define PG8_STAMP() do { if (STAMP && wid == 0 && nts < 64) { const unsigned long long _c = (unsigned long long)clock64(); \
        ts_lo = (lane == nts) ? (int)(unsigned)_c : ts_lo; ts_hi = (lane == nts) ? (int)(unsigned)(_c >> 32) : ts_hi; ++nts; } } while (0)
    PG8_STAMP();
    unsigned voffA[2], voffB[2];
#pragma unroll
    for (int i = 0; i < 2; ++i) { int R, C; stage_rc(tid * 16 + i * 8192, R, C); const int Rb = Epi::PERM ? ((R & ~31) + perm32(R & 31)) : R;
        voffA[i] = (unsigned)(R * K + C) * 2u; voffB[i] = (unsigned)(Rb * K + C) * 2u; }
    const size_t kstep = (size_t)(BK * 2);
    const size_t hstep = (size_t)HALF * K * 2;
    const size_t tstep = 2 * hstep;
    const unsigned ldsw = (unsigned)wid * 1024u;
    const int aoff = lds_byte(wr * 64 + fr, fq * 8), boff = lds_byte(wc * 32 + fr, fq * 8);
#define PG8_SA(b, h) (((b) * 2 + (h)) * HTB)
#define PG8_SB(b, h) ((4 + (b) * 2 + (h)) * HTB)
#define PG8_STAGE(bufoff, gbase, voff) do { _Pragma("unroll") for (int _i = 0; _i < 2; ++_i) \
        __builtin_amdgcn_global_load_lds((const unsigned*)((const char*)(gbase) + (voff)[_i]), (PG8_LAS unsigned*)(lds + (bufoff) + ldsw + _i * 8192), 16, 0, 0); } while (0)
#define PG8_LDA(dst, b, h) do { _Pragma("unroll") for (int m = 0; m < 4; ++m) _Pragma("unroll") for (int k = 0; k < 2; ++k) dst[m][k] = *(const PG8_LAS bf16x8*)(lds + PG8_SA(b, h) + aoff + m * 2048 + k * 1024); } while (0)
#define PG8_LDB(dst, b, h) do { _Pragma("unroll") for (int n = 0; n < 2; ++n) _Pragma("unroll") for (int k = 0; k < 2; ++k) dst[n][k] = *(const PG8_LAS bf16x8*)(lds + PG8_SB(b, h) + boff + n * 2048 + k * 1024); } while (0)
#define PG8_MMA(ai, bj, At, Bt) do { __builtin_amdgcn_s_setprio(1); _Pragma("unroll") for (int m = 0; m < 4; ++m) _Pragma("unroll") for (int n = 0; n < 2; ++n) _Pragma("unroll") for (int k = 0; k < 2; ++k) \
        acc[ai][bj][m][n] = __builtin_amdgcn_mfma_f32_16x16x32_bf16(Bt[n][k], At[m][k], acc[ai][bj][m][n], 0, 0, 0); __builtin_amdgcn_s_setprio(0); } while (0)
#define PG8_WAIT_V(n) asm volatile("s_waitcnt vmcnt(" #n ")" ::: "memory")
#define PG8_WAIT_L(n) asm volatile("s_waitcnt lgkmcnt(" #n ")" ::: "memory")
#define PG8_BAR __builtin_amdgcn_s_barrier()
#define PG8_SCHED __builtin_amdgcn_sched_barrier(0)
    Unit cur, nxt; int ui = 0;
    if (!S.next(0, cur)) return;
    f32x4 acc[2][2][4][2];
#pragma unroll
    for (int a = 0; a < 2; ++a)
#pragma unroll
        for (int b = 0; b < 2; ++b)
#pragma unroll
            for (int m = 0; m < 4; ++m)
#pragma unroll
                for (int n = 0; n < 2; ++n) acc[a][b][m][n] = (f32x4){0.f, 0.f, 0.f, 0.f};
    bf16x8 At[4][2], B0[2][2], B1[2][2];
    const char* cA = (const char*)g.A + (size_t)cur.pm * tstep; const char* cB = (const char*)g.Bt + (size_t)cur.pn * tstep;
    S.a_ready(cur);
    PG8_STAGE(PG8_SB(0, 0), cB, voffB); PG8_STAGE(PG8_SA(0, 0), cA, voffA); PG8_STAGE(PG8_SB(0, 1), cB + hstep, voffB); PG8_STAGE(PG8_SA(0, 1), cA + hstep, voffA);
    if (wr == 1) PG8_BAR;
    PG8_WAIT_V(4); PG8_BAR;
    PG8_STAGE(PG8_SB(1, 0), cB + kstep, voffB); PG8_STAGE(PG8_SA(1, 0), cA + kstep, voffA); PG8_STAGE(PG8_SB(1, 1), cB + hstep + kstep, voffB);
    PG8_WAIT_V(6); PG8_BAR;
    PG8_STAMP();
    for (;;) {
        const bool has_next = S.next(ui + 1, nxt);
        const char* nA = has_next ? (const char*)g.A + (size_t)nxt.pm * tstep : cA; const char* nB = has_next ? (const char*)g.Bt + (size_t)nxt.pn * tstep : cB;
        for (int t = 0; t < nt; t += 2) {
            const bool last = (t == nt - 2);
            const char* a1 = cA + (size_t)(t + 1) * kstep;
            const char* a2 = last ? nA : cA + (size_t)(t + 2) * kstep; const char* b2 = last ? nB : cB + (size_t)(t + 2) * kstep;
            const char* a3 = a2 + kstep; const char* b3 = b2 + kstep;
            if (last && has_next) S.a_ready(nxt);
            PG8_LDB(B0, 0, 0); PG8_SCHED; PG8_LDA(At, 0, 0); PG8_STAGE(PG8_SA(1, 1), a1 + hstep, voffA);
            PG8_WAIT_L(8); PG8_BAR; PG8_WAIT_L(0); PG8_MMA(0, 0, At, B0); PG8_BAR; PG8_SCHED;
            PG8_LDB(B1, 0, 1); PG8_STAGE(PG8_SB(0, 0), b2, voffB);
            PG8_BAR; PG8_WAIT_L(0); PG8_MMA(0, 1, At, B1); PG8_BAR;
            PG8_LDA(At, 0, 1); PG8_STAGE(PG8_SA(0, 0), a2, voffA);
            PG8_BAR; PG8_WAIT_L(0); PG8_MMA(1, 0, At, B0); PG8_BAR; PG8_SCHED;
            PG8_STAGE(PG8_SB(0, 1), b2 + hstep, voffB);
            PG8_WAIT_V(6); PG8_BAR; PG8_MMA(1, 1, At, B1); PG8_BAR;
            PG8_LDB(B0, 1, 0); PG8_SCHED; PG8_LDA(At, 1, 0); PG8_STAGE(PG8_SA(0, 1), a2 + hstep, voffA);
            PG8_WAIT_L(8); PG8_BAR; PG8_WAIT_L(0); PG8_MMA(0, 0, At, B0); PG8_BAR; PG8_SCHED;
            PG8_LDB(B1, 1, 1); PG8_STAGE(PG8_SB(1, 0), b3, voffB);
            PG8_BAR; PG8_WAIT_L(0); PG8_MMA(0, 1, At, B1); PG8_BAR;
            PG8_LDA(At, 1, 1); PG8_STAGE(PG8_SA(1, 0), a3, voffA);
            PG8_BAR; PG8_WAIT_L(0); PG8_MMA(1, 0, At, B0); PG8_BAR; PG8_SCHED;
            PG8_STAGE(PG8_SB(1, 1), b3 + hstep, voffB);
            PG8_WAIT_V(6); PG8_BAR; PG8_MMA(1, 1, At, B1); PG8_BAR;
        }
        PG8_STAMP();
        if constexpr (!Epi::AFTER_DRAIN) { E(acc, cur, wr, wc, fr, fq); S.done(cur); }
        PG8_STAMP();
        if (!has_next) break;
#pragma unroll
        for (int a = 0; a < 2; ++a)
#pragma unroll
            for (int b = 0; b < 2; ++b)
#pragma unroll
                for (int m = 0; m < 4; ++m)
#pragma unroll
                    for (int n = 0; n < 2; ++n) acc[a][b][m][n] = (f32x4){0.f, 0.f, 0.f, 0.f};
        cur = nxt; cA = nA; cB = nB; ++ui;
    }
    PG8_WAIT_V(0);
    if (wr == 0) PG8_BAR;
    PG8_BAR;
    if constexpr (Epi::AFTER_DRAIN) { E.fused(acc, cur, wr, wc, fr, fq, lds, wid, lane); S.done(cur); }
    PG8_STAMP();
    if (STAMP && wid == 0) { stamps[lane] = lane < nts ? (((unsigned long long)(unsigned)ts_hi << 32) | (unsigned)ts_lo) : 0ull;
        if (lane == 62) stamps[62] = rt_entry; if (lane == 63) stamps[63] = (unsigned long long)wall_clock64(); }
#undef PG8_STAMP
#undef PG8_SA
#undef PG8_SB
#undef PG8_STAGE
#undef PG8_LDA
#undef PG8_LDB
#undef PG8_MMA
#undef PG8_WAIT_V
#undef PG8_WAIT_L
#undef PG8_BAR
#undef PG8_SCHED
}
}

#define LAS __attribute__((address_space(3)))
typedef unsigned short u16;
typedef float f32x2 __attribute__((ext_vector_type(2)));
typedef float f32x4 __attribute__((ext_vector_type(4)));
typedef float f32x16 __attribute__((ext_vector_type(16)));
typedef unsigned u32x4 __attribute__((ext_vector_type(4)));
typedef short bf16x8 __attribute__((ext_vector_type(8)));

constexpr int S_ = 16384, D_ = 2048, PC_ = 6144, LW_ = 1024, NSUB = 1024  ;
constexpr float ALPHA_ = 1.189207115002721f;
constexpr float LOG2E_ = 1.4426950408889634f, LN2_ = 0.6931471805599453f;
constexpr size_t WS_XB = 0;
constexpr size_t WS_WINT = WS_XB + (size_t)S_ * D_ * 2;
constexpr size_t WS_WOUTT = WS_WINT + (size_t)PC_ * D_ * 2;
constexpr size_t WS_GW = WS_WOUTT + (size_t)D_ * D_ * 2;
constexpr size_t WS_K = WS_GW + (size_t)16 * 4 * 64 * 64 * 2;
constexpr size_t WS_PROJ = WS_K + 2 * 1024 * 4;
constexpr size_t WS_SUM = WS_PROJ + (size_t)S_ * PC_ * 2;
constexpr size_t WS_CAR = WS_SUM + (size_t)4 * NSUB * 1024 * 4;
constexpr size_t WS_Y = WS_CAR + (size_t)2 * NSUB * 1024 * 4;
constexpr size_t WS_STATS = WS_Y + (size_t)S_ * D_ * 2;
constexpr size_t WS_END = WS_STATS + (size_t)S_ * 32 * 2 * 4;
constexpr int LDS_BYTES = 147456;

struct Args {
    const float *x, *w_in, *conv_w, *conv_b, *wa_f, *ba_f, *wx_f, *bx_f, *lam_f, *wa_b, *ba_b, *wx_b, *bx_b, *lam_b, *sc_w, *g_lru, *g_sc, *w_out, *ln_g, *ln_b;
    float* out; unsigned char* ws; int lo, hi;
};

__device__ __forceinline__ unsigned pk_bf16(float lo, float hi) { unsigned r; asm("v_cvt_pk_bf16_f32 %0, %1, %2" : "=v"(r) : "v"(lo), "v"(hi)); return r; }
__device__ __forceinline__ u16 f2bf(float f) { return (u16)(pk_bf16(f, 0.f) & 0xffffu); }
__device__ __forceinline__ float bf2f(unsigned h) { return __uint_as_float(h << 16); }
__device__ __forceinline__ float bflo(unsigned w) { return __uint_as_float(w << 16); }
__device__ __forceinline__ float bfhi(unsigned w) { return __uint_as_float(w & 0xffff0000u); }
__device__ __forceinline__ float sigm(float z) { return __builtin_amdgcn_rcpf(1.0f + __builtin_amdgcn_exp2f(-LOG2E_ * z)); }
__device__ __forceinline__ void wave_lds_sync() { asm volatile("s_waitcnt lgkmcnt(0)" ::: "memory"); }

__device__ __forceinline__ void phase0(const Args& a, LAS unsigned char* lds) {
    const int tid = threadIdx.x; const size_t gt = (size_t)blockIdx.x * 512 + tid, GT = (size_t)gridDim.x * 512;
    {
        const f32x4* x4 = (const f32x4*)a.x; u32x4* xb = (u32x4*)(a.ws + WS_XB); const size_t n8 = (size_t)S_ * D_ / 8;
        for (size_t i = gt; i < n8; i += GT) { const f32x4 p = x4[2 * i], q = x4[2 * i + 1]; u32x4 w; w.x = pk_bf16(p[0], p[1]); w.y = pk_bf16(p[2], p[3]); w.z = pk_bf16(q[0], q[1]); w.w = pk_bf16(q[2], q[3]); xb[i] = w; }
    }
    {
        LAS float* tile = (LAS float*)lds;
        for (int ti = blockIdx.x; ti < 3072 + 1024; ti += gridDim.x) {
            const float* src; u16* dst; int N, kt, nt;
            if (ti < 3072) { src = a.w_in; dst = (u16*)(a.ws + WS_WINT); N = PC_; kt = ti / 96; nt = ti % 96; }
            else { const int v = ti - 3072; src = a.w_out; dst = (u16*)(a.ws + WS_WOUTT); N = D_; kt = v / 32; nt = v % 32; }
#pragma unroll
            for (int it = 0; it < 2; ++it) { const int r = it * 32 + (tid >> 4), c4 = (tid & 15) * 4; const f32x4 v = *(const f32x4*)(src + (size_t)(kt * 64 + r) * N + nt * 64 + c4);
                tile[r * 65 + c4 + 0] = v[0]; tile[r * 65 + c4 + 1] = v[1]; tile[r * 65 + c4 + 2] = v[2]; tile[r * 65 + c4 + 3] = v[3]; }
            __syncthreads();
            { const int nn = tid >> 3, k8 = (tid & 7) * 8; float e[8];
#pragma unroll
              for (int j = 0; j < 8; ++j) e[j] = tile[(k8 + j) * 65 + nn];
              u32x4 w; w.x = pk_bf16(e[0], e[1]); w.y = pk_bf16(e[2], e[3]); w.z = pk_bf16(e[4], e[5]); w.w = pk_bf16(e[6], e[7]);
              *(u32x4*)(dst + (size_t)(nt * 64 + nn) * D_ + kt * 64 + k8) = w; }
            __syncthreads();
        }
    }
    {
        u16* gw = (u16*)(a.ws + WS_GW);
        for (size_t idx = gt; idx < (size_t)16 * 4 * 64 * 64; idx += GT) { const int i = (int)(idx & 63), j = (int)((idx >> 6) & 63), mat = (int)((idx >> 12) & 3), hd = (int)(idx >> 14);
            const float* m = mat == 0 ? a.wa_f : mat == 1 ? a.wx_f : mat == 2 ? a.wa_b : a.wx_b; gw[idx] = f2bf(m[hd * 4096 + i * 64 + j]); }
        float* kk = (float*)(a.ws + WS_K);
        for (size_t idx = gt; idx < 2048; idx += GT) { const float lam = (idx < 1024 ? a.lam_f : a.lam_b)[idx & 1023]; const float xx = -lam;
            const float sp = fmaxf(xx, 0.f) + log1pf(expf(-fabsf(xx))); kk[idx] = -8.0f * sp * LOG2E_; }
    }
}

__device__ __forceinline__ void gate_math(float zr, float zi, float k, float u, float& a, float& bv) {
    const float r = sigm(zr), ig = sigm(zi);
    const float l2a = k * r;
    a = __builtin_amdgcn_exp2f(l2a);
    const float x = l2a * (2.0f * LN2_);
    const float p = 1.0f + x * (0.5f + x * (0.16666667f + x * (0.041666668f + x * (0.0083333338f + x * 0.0013888889f))));
    const float m2 = (x > -0.3f) ? (-x * p) : (1.0f - a * a);
    bv = __builtin_amdgcn_sqrtf(m2) * ig * u;
}

template <bool FINAL>
__device__ __forceinline__ void scan_phase(const Args& a, LAS unsigned char* lds) {
    const int tid = threadIdx.x, lane = tid & 63, wave = tid >> 6, hh = lane >> 5, n = lane & 31;
    constexpr int XS = 72;
    constexpr int YS = 1032;
    LAS u16* xt = (LAS u16*)(lds + wave * 9728);
    LAS u16* ut = (LAS u16*)(lds + wave * 9728 + 5120);
    LAS u16* ytl = (LAS u16*)(lds + 77824);
    LAS float* part_l = (LAS float*)(lds + 77824 + 66048);
    LAS float* part_s = part_l + 256;
    LAS float* scl = part_s + 64;
    const u16* proj = (const u16*)(a.ws + WS_PROJ);
    const u16* gw = (const u16*)(a.ws + WS_GW);
    const float* kk = (const float*)(a.ws + WS_K);
    float* sum = (float*)(a.ws + WS_SUM);
    const float* car = (const float*)(a.ws + WS_CAR);
    u16* Y = (u16*)(a.ws + WS_Y);
    constexpr size_t PL = (size_t)NSUB * 1024;

    for (int j = blockIdx.x; j < S_ / 32; j += gridDim.x) {
        const int t0 = j * 32;
        float ssq[16];
#pragma unroll
        for (int q = 0; q < 16; ++q) ssq[q] = 0.f;
#pragma unroll 1
        for (int h2 = 0; h2 < 2; ++h2) {
            const int hd = wave * 2 + h2;
#pragma unroll
            for (int it = 0; it < 5; ++it) { const int row = it * 8 + (lane >> 3), c8 = lane & 7;
                if (row < 35) { const int t = t0 - 2 + row; u32x4 v = (u32x4){0u, 0u, 0u, 0u};
                    if (t >= 0 && t < S_) v = *(const u32x4*)(proj + (size_t)t * PC_ + hd * 64 + c8 * 8);
                    *(LAS u32x4*)(xt + row * XS + c8 * 8) = v; } }
            wave_lds_sync();
#pragma unroll 1
            for (int nt = 0; nt < 2; ++nt) { const int c = hd * 64 + nt * 32 + n;
                const float w0 = a.conv_w[c], w1 = a.conv_w[1024 + c], w2 = a.conv_w[2048 + c], w3 = a.conv_w[3072 + c], cb = a.conv_b[c];
                float xv[19];
#pragma unroll
                for (int r = 0; r < 19; ++r) xv[r] = bf2f(xt[(16 * hh + r) * XS + nt * 32 + n]);
#pragma unroll
                for (int q = 0; q < 16; ++q) { const float uu = cb + w0 * xv[q] + w1 * xv[q + 1] + w2 * xv[q + 2] + w3 * xv[q + 3]; ut[(16 * hh + q) * XS + nt * 32 + n] = f2bf(uu); } }
            wave_lds_sync();
            bf16x8 Af[4];
            { const int r = lane & 31, tau = 16 * ((r >> 2) & 1) + 4 * (r >> 3) + (r & 3);
#pragma unroll
              for (int k4 = 0; k4 < 4; ++k4) Af[k4] = *(const LAS bf16x8*)(ut + tau * XS + k4 * 16 + 8 * hh); }
#pragma unroll 1
            for (int nt = 0; nt < 2; ++nt) {
                const int c = hd * 64 + nt * 32 + n;
                float uq[16];
#pragma unroll
                for (int q = 0; q < 16; ++q) uq[q] = bf2f(ut[(16 * hh + q) * XS + nt * 32 + n]);
                const size_t sidx = (size_t)(2 * j + hh) * 1024 + c;
                float hs[16];
#pragma unroll
                for (int dir = 0; dir < 2; ++dir) {
                    f32x16 accr, acci;
#pragma unroll
                    for (int q = 0; q < 16; ++q) { accr[q] = 0.f; acci[q] = 0.f; }
                    const u16* gwr = gw + (size_t)((hd * 4 + 2 * dir) * 64 + nt * 32 + n) * 64 + 8 * hh;
#pragma unroll
                    for (int k4 = 0; k4 < 4; ++k4) { const bf16x8 Br = *(const bf16x8*)(gwr + k4 * 16), Bi = *(const bf16x8*)(gwr + 4096 + k4 * 16);
                        accr = __builtin_amdgcn_mfma_f32_32x32x16_bf16(Af[k4], Br, accr, 0, 0, 0); acci = __builtin_amdgcn_mfma_f32_32x32x16_bf16(Af[k4], Bi, acci, 0, 0, 0); }
                    const float br = (dir ? a.ba_b : a.ba_f)[c], bi = (dir ? a.bx_b : a.bx_f)[c], kd = kk[dir * 1024 + c];
                    float av[16], bv[16];
#pragma unroll
                    for (int q = 0; q < 16; ++q) gate_math(accr[q] + br, acci[q] + bi, kd, uq[q], av[q], bv[q]);
                    if (!FINAL) {
                        float Ac = 1.f, Hc = 0.f;
#pragma unroll
                        for (int q = 0; q < 16; ++q) { const int qq = dir ? 15 - q : q; Ac *= av[qq]; Hc = av[qq] * Hc + bv[qq]; }
                        sum[(size_t)(2 * dir) * PL + sidx] = Ac; sum[(size_t)(2 * dir + 1) * PL + sidx] = Hc;
                    } else {
                        float h = car[(size_t)dir * PL + sidx];
#pragma unroll
                        for (int q = 0; q < 16; ++q) { const int qq = dir ? 15 - q : q; h = av[qq] * h + bv[qq]; if (dir == 0) hs[qq] = h; else hs[qq] += h; }
                    }
                }
                if (FINAL) {
#pragma unroll
                    for (int q = 0; q < 16; ++q) { const float g = bf2f(proj[(size_t)(t0 + 16 * hh + q) * PC_ + 1024 + c]); const float v = hs[q] * g * sigm(g); ytl[(16 * hh + q) * YS + c] = f2bf(v); ssq[q] += v * v; }
                }
            }
            wave_lds_sync();
        }
        if (FINAL) {
            const int cgp = tid & 127, c0 = cgp * 8, rq = tid >> 7;
            float w0[8], w1[8], w2[8];
#pragma unroll
            for (int e = 0; e < 8; ++e) { w0[e] = a.sc_w[c0 + e]; w1[e] = a.sc_w[1024 + c0 + e]; w2[e] = a.sc_w[2048 + c0 + e]; }
            float prev[8], cur[8], nxt[8], ss[8]; unsigned qp[8][4];
            auto loadp = [&](int t, float (&p)[8]) {
                if (t >= 0 && t < S_) { const u32x4 cv = *(const u32x4*)(proj + (size_t)t * PC_ + 3072 + c0), hv = *(const u32x4*)(proj + (size_t)t * PC_ + 4096 + c0);
                    p[0] = bflo(cv.x) * bflo(hv.x); p[1] = bfhi(cv.x) * bfhi(hv.x); p[2] = bflo(cv.y) * bflo(hv.y); p[3] = bfhi(cv.y) * bfhi(hv.y);
                    p[4] = bflo(cv.z) * bflo(hv.z); p[5] = bfhi(cv.z) * bfhi(hv.z); p[6] = bflo(cv.w) * bflo(hv.w); p[7] = bfhi(cv.w) * bfhi(hv.w); }
                else {
#pragma unroll
                    for (int e = 0; e < 8; ++e) p[e] = 0.f; } };
            const int tb = t0 + rq * 8;
            loadp(tb - 1, prev); loadp(tb, cur);
#pragma unroll
            for (int r = 0; r < 8; ++r) { const int t = tb + r; loadp(t + 1, nxt);
                const u32x4 bv4 = *(const u32x4*)(proj + (size_t)t * PC_ + 2048 + c0), gv4 = *(const u32x4*)(proj + (size_t)t * PC_ + 5120 + c0);
                float bvv[8] = {bflo(bv4.x), bfhi(bv4.x), bflo(bv4.y), bfhi(bv4.y), bflo(bv4.z), bfhi(bv4.z), bflo(bv4.w), bfhi(bv4.w)};
                float gvv[8] = {bflo(gv4.x), bfhi(gv4.x), bflo(gv4.y), bfhi(gv4.y), bflo(gv4.z), bfhi(gv4.z), bflo(gv4.w), bfhi(gv4.w)};
                float s = 0.f, qq[8];
#pragma unroll
                for (int e = 0; e < 8; ++e) { const float v = w0[e] * prev[e] + w1[e] * cur[e] + w2[e] * nxt[e]; qq[e] = bvv[e] * v * gvv[e] * sigm(gvv[e]); s += qq[e] * qq[e]; prev[e] = cur[e]; cur[e] = nxt[e]; }
#pragma unroll
                for (int e = 0; e < 4; ++e) qp[r][e] = pk_bf16(qq[2 * e], qq[2 * e + 1]);
                ss[r] = s; }
            {   const bool b4 = (n & 16) != 0, b3 = (n & 8) != 0, b2 = (n & 4) != 0, b1 = (n & 2) != 0;
                float v8[8], v4[4], v2[2], v1;
#pragma unroll
                for (int i = 0; i < 8; ++i) { const float snd = b4 ? ssq[i] : ssq[i + 8]; const float rcv = __shfl_xor(snd, 16); v8[i] = (b4 ? ssq[i + 8] : ssq[i]) + rcv; }
#pragma unroll
                for (int i = 0; i < 4; ++i) { const float snd = b3 ? v8[i] : v8[i + 4]; const float rcv = __shfl_xor(snd, 8); v4[i] = (b3 ? v8[i + 4] : v8[i]) + rcv; }
#pragma unroll
                for (int i = 0; i < 2; ++i) { const float snd = b2 ? v4[i] : v4[i + 2]; const float rcv = __shfl_xor(snd, 4); v2[i] = (b2 ? v4[i + 2] : v4[i]) + rcv; }
                { const float snd = b1 ? v2[0] : v2[1]; const float rcv = __shfl_xor(snd, 2); v1 = (b1 ? v2[1] : v2[0]) + rcv; }
                v1 += __shfl_xor(v1, 1);
                if ((n & 1) == 0) part_l[wave * 32 + 16 * hh + (n >> 1)] = v1; }
            {   const bool b5 = (lane & 32) != 0, b4 = (lane & 16) != 0, b3 = (lane & 8) != 0;
                float v4[4], v2[2], v1;
#pragma unroll
                for (int i = 0; i < 4; ++i) { const float snd = b5 ? ss[i] : ss[i + 4]; const float rcv = __shfl_xor(snd, 32); v4[i] = (b5 ? ss[i + 4] : ss[i]) + rcv; }
#pragma unroll
                for (int i = 0; i < 2; ++i) { const float snd = b4 ? v4[i] : v4[i + 2]; const float rcv = __shfl_xor(snd, 16); v2[i] = (b4 ? v4[i + 2] : v4[i]) + rcv; }
                { const float snd = b3 ? v2[0] : v2[1]; const float rcv = __shfl_xor(snd, 8); v1 = (b3 ? v2[1] : v2[0]) + rcv; }
                v1 += __shfl_xor(v1, 4); v1 += __shfl_xor(v1, 2); v1 += __shfl_xor(v1, 1);
                if ((lane & 7) == 0) part_s[wave * 8 + (lane >> 3)] = v1; }
            __syncthreads();
            if (tid < 32) { float s = 0.f;
#pragma unroll
                for (int w = 0; w < 8; ++w) s += part_l[w * 32 + tid];
                scl[tid] = __builtin_amdgcn_rsqf(s * (1.0f / 1024.0f) + 1e-6f); }
            else if (tid < 64) { const int t = tid - 32, g = t >> 3, r = t & 7; const float s = part_s[(2 * g) * 8 + r] + part_s[(2 * g + 1) * 8 + r];
                scl[32 + t] = __builtin_amdgcn_rsqf(s * (1.0f / 1024.0f) + 1e-6f); }
            __syncthreads();
            { float gl[8], gs[8];
#pragma unroll
              for (int e = 0; e < 8; ++e) { gl[e] = a.g_lru[c0 + e]; gs[e] = a.g_sc[c0 + e]; }
#pragma unroll
              for (int r = 0; r < 8; ++r) { const float sl = scl[rq * 8 + r], s = scl[32 + rq * 8 + r];
                  const u32x4 hv = *(const LAS u32x4*)(ytl + (rq * 8 + r) * YS + c0); u32x4 w;
                  w.x = pk_bf16(bflo(hv.x) * sl * gl[0], bfhi(hv.x) * sl * gl[1]); w.y = pk_bf16(bflo(hv.y) * sl * gl[2], bfhi(hv.y) * sl * gl[3]);
                  w.z = pk_bf16(bflo(hv.z) * sl * gl[4], bfhi(hv.z) * sl * gl[5]); w.w = pk_bf16(bflo(hv.w) * sl * gl[6], bfhi(hv.w) * sl * gl[7]);
                  *(u32x4*)(Y + (size_t)(tb + r) * D_ + c0) = w;
                  w.x = pk_bf16(bflo(qp[r][0]) * s * gs[0], bfhi(qp[r][0]) * s * gs[1]); w.y = pk_bf16(bflo(qp[r][1]) * s * gs[2], bfhi(qp[r][1]) * s * gs[3]);
                  w.z = pk_bf16(bflo(qp[r][2]) * s * gs[4], bfhi(qp[r][2]) * s * gs[5]); w.w = pk_bf16(bflo(qp[r][3]) * s * gs[6], bfhi(qp[r][3]) * s * gs[7]);
                  *(u32x4*)(Y + (size_t)(tb + r) * D_ + 1024 + c0) = w; } }
            __syncthreads();
        }
    }
}

template <bool REV>
__device__ __forceinline__ void carry_unit(const float* SA, const float* SH, float* CO, int c, int g, int cl, LAS float* gA, LAS float* gH) {
    float A[32], H[32];
#pragma unroll
    for (int s = 0; s < 32; ++s) { const size_t k = (size_t)(g * 32 + s); A[s] = SA[k * 1024 + c]; H[s] = SH[k * 1024 + c]; }
    float Ag = 1.f, Hg = 0.f;
#pragma unroll
    for (int s = 0; s < 32; ++s) { const int sr = REV ? 31 - s : s; Ag *= A[sr]; Hg = A[sr] * Hg + H[sr]; }
    gA[g * 16 + cl] = Ag; gH[g * 16 + cl] = Hg;
    __syncthreads();
    float h = 0.f;
    if (!REV) { for (int gg = 0; gg < g; ++gg) h = gA[gg * 16 + cl] * h + gH[gg * 16 + cl]; }
    else { for (int gg = 31; gg > g; --gg) h = gA[gg * 16 + cl] * h + gH[gg * 16 + cl]; }
#pragma unroll
    for (int s = 0; s < 32; ++s) { const int sr = REV ? 31 - s : s; CO[(size_t)(g * 32 + sr) * 1024 + c] = h; h = A[sr] * h + H[sr]; }
    __syncthreads();
}
__device__ __forceinline__ void carry_phase(const Args& a, LAS unsigned char* lds) {
    const int tid = threadIdx.x, cl = tid & 15, g = tid >> 4;
    LAS float* gA = (LAS float*)lds; LAS float* gH = gA + 512;
    const float* sum = (const float*)(a.ws + WS_SUM); float* car = (float*)(a.ws + WS_CAR);
    constexpr size_t PL = (size_t)NSUB * 1024;
    for (int bu = blockIdx.x; bu < 128; bu += gridDim.x) {
        const int dir = bu >> 6, c = (bu & 63) * 16 + cl;
        if (dir == 0) carry_unit<false>(sum, sum + PL, car, c, g, cl, gA, gH);
        else carry_unit<true>(sum + 2 * PL, sum + 3 * PL, car + PL, c, g, cl, gA, gH);
    }
}

__device__ __forceinline__ void ln_phase(const Args& a) {
    const int tid = threadIdx.x, lane = tid & 63, wave = tid >> 6;
    const f32x2* stats = (const f32x2*)(a.ws + WS_STATS);
    for (int row = blockIdx.x * 8 + wave; row < S_; row += gridDim.x * 8) {
        f32x2 st = (f32x2){0.f, 0.f};
        if (lane < 32) st = stats[(size_t)row * 32 + lane];
        float s = st.x, q = st.y;
#pragma unroll
        for (int o = 32; o >= 1; o >>= 1) { s += __shfl_xor(s, o); q += __shfl_xor(q, o); }
        const float mean = s * (1.0f / 2048.0f), var = fmaxf(q * (1.0f / 2048.0f) - mean * mean, 0.f), rstd = __builtin_amdgcn_rsqf(var + 1e-5f);
        float* zr = a.out + (size_t)row * D_;
#pragma unroll
        for (int i = 0; i < 8; ++i) { const int col = i * 256 + lane * 4; const f32x4 z = *(const f32x4*)(zr + col), g = *(const f32x4*)(a.ln_g + col), b = *(const f32x4*)(a.ln_b + col);
            *(f32x4*)(zr + col) = (z - mean) * rstd * g + b; }
    }
}

__global__ void __launch_bounds__(512, 2) fwd_kernel(Args a) {
    extern __shared__ __attribute__((aligned(16))) unsigned char shm[];
    LAS unsigned char* lds = (LAS unsigned char*)shm;
    cg::grid_group grid = cg::this_grid();
#define IN(k) (a.lo <= (k) && (k) < a.hi)
#define SEAM(k) do { if (IN(k) && IN((k) + 1)) grid.sync(); } while (0)
#ifndef SKIP0
    if (IN(0)) phase0(a, lds);
#endif
    SEAM(0);
#ifndef SKIP1
    if (IN(1)) { pg8::Gemm g{(const pg8::bf16_t*)(a.ws + WS_XB), (const pg8::bf16_t*)(a.ws + WS_WINT), S_, PC_, D_}; pg8::StaticOrder S; S.init(S_, PC_, (int)gridDim.x, (int)blockIdx.x);
        pg8::EpiBf16<0> E{(pg8::bf16_t*)(a.ws + WS_PROJ), PC_, nullptr, 0, 0};
        pg8::gemm_phase<pg8::EpiBf16<0>, pg8::StaticOrder, false>(lds, g, S, E, nullptr); }
#endif
    SEAM(1);
#ifndef SKIP2
    if (IN(2)) scan_phase<false>(a, lds);
#endif
    SEAM(2);
#ifndef SKIP3
    if (IN(3)) carry_phase(a, lds);
#endif
    SEAM(3);
#ifndef SKIP4
    if (IN(4)) scan_phase<true>(a, lds);
#endif
    SEAM(4);
#ifndef SKIP5
    if (IN(5)) { pg8::Gemm g{(const pg8::bf16_t*)(a.ws + WS_Y), (const pg8::bf16_t*)(a.ws + WS_WOUTT), S_, D_, D_}; pg8::StaticOrder S; S.init(S_, D_, (int)gridDim.x, (int)blockIdx.x);
        pg8::EpiZ E{a.out, a.x, (float*)(a.ws + WS_STATS), D_, ALPHA_};
        pg8::gemm_phase<pg8::EpiZ, pg8::StaticOrder, false>(lds, g, S, E, nullptr); }
#endif
    SEAM(5);
#ifndef SKIP6
    if (IN(6)) ln_phase(a);
#endif
#undef IN
#undef SEAM
}

extern "C" void kernel_launch(void* const* d_in, const int* in_sizes, int n_in, void* d_out, int out_size, void* d_ws, size_t ws_size, hipStream_t stream) {
    static int grid = 0;
    if (grid == 0) {
        if (n_in != 20 || in_sizes[0] != S_ * D_ || out_size != S_ * D_ || ws_size < WS_END) { fprintf(stderr, "kernel_launch: unexpected shapes (n_in %d, in0 %d, out %d, ws %zu < %zu)\n", n_in, n_in > 0 ? in_sizes[0] : -1, out_size, ws_size, (size_t)WS_END); grid = -1; return; }
        int dev = 0, cus = 0, per_cu = 0;
        if (hipGetDevice(&dev) != hipSuccess || hipDeviceGetAttribute(&cus, hipDeviceAttributeMultiprocessorCount, dev) != hipSuccess) { grid = -1; return; }
        if (hipFuncSetAttribute((const void*)fwd_kernel, hipFuncAttributeMaxDynamicSharedMemorySize, LDS_BYTES) != hipSuccess) { fprintf(stderr, "kernel_launch: hipFuncSetAttribute failed\n"); grid = -1; return; }
        if (hipOccupancyMaxActiveBlocksPerMultiprocessor(&per_cu, (const void*)fwd_kernel, 512, LDS_BYTES) != hipSuccess || per_cu < 1) { fprintf(stderr, "kernel_launch: occupancy query says %d blocks per CU\n", per_cu); per_cu = 1; (void)hipGetLastError(); }
        grid = cus * per_cu;
    }
    if (grid < 0) return;
    Args a{};
    const float** ap = (const float**)&a;
    for (int i = 0; i < 20; ++i) ap[i] = (const float*)d_in[i];
    a.out = (float*)d_out; a.ws = (unsigned char*)d_ws;
#if MK_LAUNCHES == 1
    a.lo = 0; a.hi = 7;
    void* args[] = {&a};
    hipError_t e = hipLaunchCooperativeKernel((const void*)fwd_kernel, dim3(grid), dim3(512), args, LDS_BYTES, stream);
    if (e != hipSuccess) fprintf(stderr, "cooperative launch failed: %s (grid %d)\n", hipGetErrorString(e), grid);
#else
    for (int p = 0; p < 7; ++p) { a.lo = p; a.hi = p + 1; hipLaunchKernelGGL(fwd_kernel, dim3(grid), dim3(512), LDS_BYTES, stream, a); }
#endif
}
```

```cpp
#include <hip/hip_runtime.h>
#include <hip/hip_cooperative_groups.h>
#include <cstdio>
namespace cg = cooperative_groups;

#ifndef MK_LAUNCHES
#define MK_LAUNCHES 1
#endif

namespace pg8 {
#define PG8_LAS __attribute__((address_space(3)))
typedef unsigned short bf16_t;
typedef short bf16x8 __attribute__((ext_vector_type(8)));
typedef float f32x4 __attribute__((ext_vector_type(4)));
typedef unsigned u32x4 __attribute__((ext_vector_type(4)));
constexpr int BM = 256, BK = 64, HALF = 128, HTB = HALF * BK * 2  , STAGE_BYTES = 8 * HTB, NXCD = 8, WGM = 8;

__host__ __device__ __forceinline__ int lds_byte(int r, int c) { const int st = (r >> 4) * 2 + (c >> 5), rr = r & 15, cc = c & 31, ob = rr * 64 + cc * 2; return st * 1024 + (ob ^ (((ob >> 9) & 1) << 5)); }
__host__ __device__ __forceinline__ void stage_rc(int b, int& R, int& C) { const int st = b / 1024, sb = b % 1024, swz = sb ^ (((sb >> 9) & 1) << 5); R = (st >> 1) * 16 + swz / 64; C = (st & 1) * 32 + (swz % 64) / 2; }
__host__ __device__ __forceinline__ int perm32(int rho) { const int n = rho >> 4, i = rho & 15; return 8 * (i >> 2) + 4 * n + (i & 3); }

struct Unit { int pm, pn; };
struct Gemm { const bf16_t* A; const bf16_t* Bt; int M, N, K; };

struct StaticOrder {
    int nM, nN, nwg, G, c;
    __host__ __device__ void init(int M, int N, int G_, int c_) { nM = M / BM; nN = N / BM; nwg = nM * nN; G = G_; c = c_; }
    __host__ __device__ bool next(int i, Unit& u) const {
        const long L = (long)i * G + c; if (L >= nwg) return false;
        int wgid = (int)L; { const int q = nwg / NXCD, r = nwg % NXCD, xcd = wgid % NXCD, off = wgid / NXCD; wgid = (xcd < r ? xcd * (q + 1) : r * (q + 1) + (xcd - r) * q) + off; }
        const int nig = WGM * nN, gid = wgid / nig, fm = gid * WGM, gsz = (nM - fm) < WGM ? (nM - fm) : WGM;
        u.pm = fm + ((wgid % nig) % gsz); u.pn = (wgid % nig) / gsz; return true;
    }
    __device__ __forceinline__ void a_ready(const Unit&) const {}
    __device__ __forceinline__ void done(const Unit&) const {}
};
__device__ __forceinline__ unsigned cvt_pk_bf16(float lo, float hi) { unsigned r; asm volatile("v_cvt_pk_bf16_f32 %0, %1, %2" : "=v"(r) : "v"(lo), "v"(hi)); return r; }
typedef float f32x2 __attribute__((ext_vector_type(2)));
__device__ __forceinline__ f32x2 gelu_pk(f32x2 v) {
    const f32x2 av = __builtin_elementwise_abs(v), d = av * 0.2316418882f + 1.0f;
    f32x2 t; t.x = __builtin_amdgcn_rcpf(d.x); t.y = __builtin_amdgcn_rcpf(d.y);
    f32x2 q = t * 0.5307027145f + (-0.7265760135f); q = q * t + 0.7107068705f; q = q * t + (-0.142248368f); q = q * t + 0.127414796f; q = q * t;
    const f32x2 s = (v * v) * (-0.72134752044f);
    f32x2 e; e.x = __builtin_amdgcn_exp2f(s.x); e.y = __builtin_amdgcn_exp2f(s.y);
    const f32x2 m = v * (q * e), r = v - m;
    f32x2 o; o.x = v.x < 0.f ? m.x : r.x; o.y = v.y < 0.f ? m.y : r.y; return o;
}

struct EpiF32 {
    static constexpr bool PERM = false, AFTER_DRAIN = false;
    float* C; int ldc; const float* bias;
    __device__ __forceinline__ void operator()(const f32x4 (&acc)[2][2][4][2], const Unit& u, int wr, int wc, int fr, int fq) const {
        const int row0 = u.pm * BM + wr * 64 + fr, col0 = u.pn * BM + wc * 32 + 4 * fq;
        f32x4 bv[2][2];
#pragma unroll
        for (int bj = 0; bj < 2; ++bj)
#pragma unroll
            for (int n = 0; n < 2; ++n) bv[bj][n] = bias ? *(const f32x4*)(bias + col0 + bj * HALF + n * 16) : (f32x4){0.f, 0.f, 0.f, 0.f};
#pragma unroll
        for (int ai = 0; ai < 2; ++ai)
#pragma unroll
            for (int m = 0; m < 4; ++m) { float* rowp = C + (size_t)(row0 + ai * HALF + m * 16) * ldc + col0;
#pragma unroll
                for (int bj = 0; bj < 2; ++bj)
#pragma unroll
                    for (int n = 0; n < 2; ++n) *(f32x4*)(rowp + bj * HALF + n * 16) = acc[ai][bj][m][n] + bv[bj][n]; }
    }
};
template <int ACT  > struct EpiBf16 {
    static constexpr bool PERM = true, AFTER_DRAIN = false;
    bf16_t* O; int ldc; const float* bias; int split_cols; size_t split_stride;
    __device__ __forceinline__ void operator()(const f32x4 (&acc)[2][2][4][2], const Unit& u, int wr, int wc, int fr, int fq) const {
        const int row0 = u.pm * BM + wr * 64 + fr; int colt = u.pn * BM; bf16_t* base = O;
        if (split_cols) { const int t = colt / split_cols; base += (size_t)t * split_stride; colt -= t * split_cols; }
        const int col0 = colt + wc * 32 + 8 * fq, bcol0 = u.pn * BM + wc * 32 + 8 * fq;
        f32x4 bv[2][2];
#pragma unroll
        for (int bj = 0; bj < 2; ++bj)
#pragma unroll
            for (int n = 0; n < 2; ++n) bv[bj][n] = bias ? *(const f32x4*)(bias + bcol0 + bj * HALF + 4 * n) : (f32x4){0.f, 0.f, 0.f, 0.f};
#pragma unroll
        for (int ai = 0; ai < 2; ++ai)
#pragma unroll
            for (int m = 0; m < 4; ++m) { bf16_t* rowp = base + (size_t)(row0 + ai * HALF + m * 16) * ldc + col0;
#pragma unroll
                for (int bj = 0; bj < 2; ++bj) { f32x4 v0 = acc[ai][bj][m][0] + bv[bj][0], v1 = acc[ai][bj][m][1] + bv[bj][1];
                    if (ACT == 1) { f32x2 a = gelu_pk((f32x2){v0[0], v0[1]}), b = gelu_pk((f32x2){v0[2], v0[3]}), c = gelu_pk((f32x2){v1[0], v1[1]}), d = gelu_pk((f32x2){v1[2], v1[3]});
                        v0 = (f32x4){a.x, a.y, b.x, b.y}; v1 = (f32x4){c.x, c.y, d.x, d.y}; }
                    if (ACT == 2) {
#pragma unroll
                        for (int j = 0; j < 4; ++j) { v0[j] = 0.5f * v0[j] * (1.0f + erff(v0[j] * 0.70710678f)); v1[j] = 0.5f * v1[j] * (1.0f + erff(v1[j] * 0.70710678f)); } }
                    u32x4 w; w.x = cvt_pk_bf16(v0[0], v0[1]); w.y = cvt_pk_bf16(v0[2], v0[3]); w.z = cvt_pk_bf16(v1[0], v1[1]); w.w = cvt_pk_bf16(v1[2], v1[3]);
                    *(u32x4*)(rowp + bj * HALF) = w; } }
    }
};
struct EpiZ {
    static constexpr bool PERM = false, AFTER_DRAIN = false;
    float* Z; const float* X; float* stats; int ldc; float alpha;
    __device__ __forceinline__ void operator()(const f32x4 (&acc)[2][2][4][2], const Unit& u, int wr, int wc, int fr, int fq) const {
        const int row0 = u.pm * BM + wr * 64 + fr, col0 = u.pn * BM + wc * 32 + 4 * fq;
#pragma unroll
        for (int ai = 0; ai < 2; ++ai)
#pragma unroll
            for (int m = 0; m < 4; ++m) { const int row = row0 + ai * HALF + m * 16; const size_t off = (size_t)row * ldc + col0; float s = 0.f, q = 0.f;
#pragma unroll
                for (int bj = 0; bj < 2; ++bj)
#pragma unroll
                    for (int n = 0; n < 2; ++n) { const f32x4 xv = *(const f32x4*)(X + off + bj * HALF + n * 16); const f32x4 z = acc[ai][bj][m][n] + alpha * xv;
                        *(f32x4*)(Z + off + bj * HALF + n * 16) = z; s += (z[0] + z[1]) + (z[2] + z[3]); q += (z[0] * z[0] + z[1] * z[1]) + (z[2] * z[2] + z[3] * z[3]); }
                s += __shfl_xor(s, 16); s += __shfl_xor(s, 32); q += __shfl_xor(q, 16); q += __shfl_xor(q, 32);
                if (fq == 0) { typedef float f32x2 __attribute__((ext_vector_type(2))); *(f32x2*)(stats + ((size_t)row * 32 + u.pn * 4 + wc) * 2) = (f32x2){s, q}; }
                asm volatile("" ::: "memory"); }
    }
};

template <class Epi, class Sched, bool STAMP = false>
__device__ __forceinline__ void gemm_phase(PG8_LAS unsigned char* lds, const Gemm g, const Sched& S, const Epi& E, unsigned long long* stamps) {
    const int tid = threadIdx.x, wid = __builtin_amdgcn_readfirstlane(tid >> 6), lane = tid & 63, wr = wid >> 2, wc = wid & 3, fr = lane & 15, fq = lane >> 4;
    const int K = g.K, nt = K / BK;
    int ts_lo = 0, ts_hi = 0, nts = 0; const unsigned long long rt_entry = STAMP ? (unsigned long long)wall_clock64() : 0ull;
#define PG8_STAMP() do { if (STAMP && wid == 0 && nts < 64) { const unsigned long long _c = (unsigned long long)clock64(); \
        ts_lo = (lane == nts) ? (int)(unsigned)_c : ts_lo; ts_hi = (lane == nts) ? (int)(unsigned)(_c >> 32) : ts_hi; ++nts; } } while (0)
    PG8_STAMP();
    unsigned voffA[2], voffB[2];
#pragma unroll
    for (int i = 0; i < 2; ++i) { int R, C; stage_rc(tid * 16 + i * 8192, R, C); const int Rb = Epi::PERM ? ((R & ~31) + perm32(R & 31)) : R;
        voffA[i] = (unsigned)(R * K + C) * 2u; voffB[i] = (unsigned)(Rb * K + C) * 2u; }
    const size_t kstep = (size_t)(BK * 2);
    const size_t hstep = (size_t)HALF * K * 2;
    const size_t tstep = 2 * hstep;
    const unsigned ldsw = (unsigned)wid * 1024u;
    const int aoff = lds_byte(wr * 64 + fr, fq * 8), boff = lds_byte(wc * 32 + fr, fq * 8);
#define PG8_SA(b, h) (((b) * 2 + (h)) * HTB)
#define PG8_SB(b, h) ((4 + (b) * 2 + (h)) * HTB)
#define PG8_STAGE(bufoff, gbase, voff) do { _Pragma("unroll") for (int _i = 0; _i < 2; ++_i) \
        __builtin_amdgcn_global_load_lds((const unsigned*)((const char*)(gbase) + (voff)[_i]), (PG8_LAS unsigned*)(lds + (bufoff) + ldsw + _i * 8192), 16, 0, 0); } while (0)
#define PG8_LDA(dst, b, h) do { _Pragma("unroll") for (int m = 0; m < 4; ++m) _Pragma("unroll") for (int k = 0; k < 2; ++k) dst[m][k] = *(const PG8_LAS bf16x8*)(lds + PG8_SA(b, h) + aoff + m * 2048 + k * 1024); } while (0)
#define PG8_LDB(dst, b, h) do { _Pragma("unroll") for (int n = 0; n < 2; ++n) _Pragma("unroll") for (int k = 0; k < 2; ++k) dst[n][k] = *(const PG8_LAS bf16x8*)(lds + PG8_SB(b, h) + boff + n * 2048 + k * 1024); } while (0)
#define PG8_MMA(ai, bj, At, Bt) do { __builtin_amdgcn_s_setprio(1); _Pragma("unroll") for (int m = 0; m < 4; ++m) _Pragma("unroll") for (int n = 0; n < 2; ++n) _Pragma("unroll") for (int k = 0; k < 2; ++k) \
        acc[ai][bj][m][n] = __builtin_amdgcn_mfma_f32_16x16x32_bf16(Bt[n][k], At[m][k], acc[ai][bj][m][n], 0, 0, 0); __builtin_amdgcn_s_setprio(0); } while (0)
#define PG8_WAIT_V(n) asm volatile("s_waitcnt vmcnt(" #n ")" ::: "memory")
#define PG8_WAIT_L(n) asm volatile("s_waitcnt lgkmcnt(" #n ")" ::: "memory")
#define PG8_BAR __builtin_amdgcn_s_barrier()
#define PG8_SCHED __builtin_amdgcn_sched_barrier(0)
    Unit cur, nxt; int ui = 0;
    if (!S.next(0, cur)) return;
    f32x4 acc[2][2][4][2];
#pragma unroll
    for (int a = 0; a < 2; ++a)
#pragma unroll
        for (int b = 0; b < 2; ++b)
#pragma unroll
            for (int m = 0; m < 4; ++m)
#pragma unroll
                for (int n = 0; n < 2; ++n) acc[a][b][m][n] = (f32x4){0.f, 0.f, 0.f, 0.f};
    bf16x8 At[4][2], B0[2][2], B1[2][2];
    const char* cA = (const char*)g.A + (size_t)cur.pm * tstep; const char* cB = (const char*)g.Bt + (size_t)cur.pn * tstep;
    S.a_ready(cur);
    PG8_STAGE(PG8_SB(0, 0), cB, voffB); PG8_STAGE(PG8_SA(0, 0), cA, voffA); PG8_STAGE(PG8_SB(0, 1), cB + hstep, voffB); PG8_STAGE(PG8_SA(0, 1), cA + hstep, voffA);
    if (wr == 1) PG8_BAR;
    PG8_WAIT_V(4); PG8_BAR;
    PG8_STAGE(PG8_SB(1, 0), cB + kstep, voffB); PG8_STAGE(PG8_SA(1, 0), cA + kstep, voffA); PG8_STAGE(PG8_SB(1, 1), cB + hstep + kstep, voffB);
    PG8_WAIT_V(6); PG8_BAR;
    PG8_STAMP();
    for (;;) {
        const bool has_next = S.next(ui + 1, nxt);
        const char* nA = has_next ? (const char*)g.A + (size_t)nxt.pm * tstep : cA; const char* nB = has_next ? (const char*)g.Bt + (size_t)nxt.pn * tstep : cB;
        for (int t = 0; t < nt; t += 2) {
            const bool last = (t == nt - 2);
            const char* a1 = cA + (size_t)(t + 1) * kstep;
            const char* a2 = last ? nA : cA + (size_t)(t + 2) * kstep; const char* b2 = last ? nB : cB + (size_t)(t + 2) * kstep;
            const char* a3 = a2 + kstep; const char* b3 = b2 + kstep;
            if (last && has_next) S.a_ready(nxt);
            PG8_LDB(B0, 0, 0); PG8_SCHED; PG8_LDA(At, 0, 0); PG8_STAGE(PG8_SA(1, 1), a1 + hstep, voffA);
            PG8_WAIT_L(8); PG8_BAR; PG8_WAIT_L(0); PG8_MMA(0, 0, At, B0); PG8_BAR; PG8_SCHED;
            PG8_LDB(B1, 0, 1); PG8_STAGE(PG8_SB(0, 0), b2, voffB);
            PG8_BAR; PG8_WAIT_L(0); PG8_MMA(0, 1, At, B1); PG8_BAR;
            PG8_LDA(At, 0, 1); PG8_STAGE(PG8_SA(0, 0), a2, voffA);
            PG8_BAR; PG8_WAIT_L(0); PG8_MMA(1, 0, At, B0); PG8_BAR; PG8_SCHED;
            PG8_STAGE(PG8_SB(0, 1), b2 + hstep, voffB);
            PG8_WAIT_V(6); PG8_BAR; PG8_MMA(1, 1, At, B1); PG8_BAR;
            PG8_LDB(B0, 1, 0); PG8_SCHED; PG8_LDA(At, 1, 0); PG8_STAGE(PG8_SA(0, 1), a2 + hstep, voffA);
            PG8_WAIT_L(8); PG8_BAR; PG8_WAIT_L(0); PG8_MMA(0, 0, At, B0); PG8_BAR; PG8_SCHED;
            PG8_LDB(B1, 1, 1); PG8_STAGE(PG8_SB(1, 0), b3, voffB);
            PG8_BAR; PG8_WAIT_L(0); PG8_MMA(0, 1, At, B1); PG8_BAR;
            PG8_LDA(At, 1, 1); PG8_STAGE(PG8_SA(1, 0), a3, voffA);
            PG8_BAR; PG8_WAIT_L(0); PG8_MMA(1, 0, At, B0); PG8_BAR; PG8_SCHED;
            PG8_STAGE(PG8_SB(1, 1), b3 + hstep, voffB);
            PG8_WAIT_V(6); PG8_BAR; PG8_MMA(1, 1, At, B1); PG8_BAR;
        }
        PG8_STAMP();
        if constexpr (!Epi::AFTER_DRAIN) { E(acc, cur, wr, wc, fr, fq); S.done(cur); }
        PG8_STAMP();
        if (!has_next) break;
#pragma unroll
        for (int a = 0; a < 2; ++a)
#pragma unroll
            for (int b = 0; b < 2; ++b)
#pragma unroll
                for (int m = 0; m < 4; ++m)
#pragma unroll
                    for (int n = 0; n < 2; ++n) acc[a][b][m][n] = (f32x4){0.f, 0.f, 0.f, 0.f};
        cur = nxt; cA = nA; cB = nB; ++ui;
    }
    PG8_WAIT_V(0);
    if (wr == 0) PG8_BAR;
    PG8_BAR;
    if constexpr (Epi::AFTER_DRAIN) { E.fused(acc, cur, wr, wc, fr, fq, lds, wid, lane); S.done(cur); }
    PG8_STAMP();
    if (STAMP && wid == 0) { stamps[lane] = lane < nts ? (((unsigned long long)(unsigned)ts_hi << 32) | (unsigned)ts_lo) : 0ull;
        if (lane == 62) stamps[62] = rt_entry; if (lane == 63) stamps[63] = (unsigned long long)wall_clock64(); }
#undef PG8_STAMP
#undef PG8_SA
#undef PG8_SB
#undef PG8_STAGE
#undef PG8_LDA
#undef PG8_LDB
#undef PG8_MMA
#undef PG8_WAIT_V
#undef PG8_WAIT_L
#undef PG8_BAR
#undef PG8_SCHED
}
}

#define LAS __attribute__((address_space(3)))
typedef unsigned short u16;
typedef float f32x2 __attribute__((ext_vector_type(2)));
typedef float f32x4 __attribute__((ext_vector_type(4)));
typedef float f32x16 __attribute__((ext_vector_type(16)));
typedef unsigned u32x4 __attribute__((ext_vector_type(4)));
typedef short bf16x8 __attribute__((ext_vector_type(8)));

constexpr int S_ = 16384, D_ = 2048, PC_ = 6144, LW_ = 1024, NSUB = 1024  ;
constexpr float ALPHA_ = 1.189207115002721f;
constexpr float LOG2E_ = 1.4426950408889634f, LN2_ = 0.6931471805599453f;
constexpr size_t WS_XB = 0;
constexpr size_t WS_WINT = WS_XB + (size_t)S_ * D_ * 2;
constexpr size_t WS_WOUTT = WS_WINT + (size_t)PC_ * D_ * 2;
constexpr size_t WS_GW = WS_WOUTT + (size_t)D_ * D_ * 2;
constexpr size_t WS_K = WS_GW + (size_t)16 * 4 * 64 * 64 * 2;
constexpr size_t WS_PROJ = WS_K + 2 * 1024 * 4;
constexpr size_t WS_SUM = WS_PROJ + (size_t)S_ * PC_ * 2;
constexpr size_t WS_CAR = WS_SUM + (size_t)4 * NSUB * 1024 * 4;
constexpr size_t WS_Y = WS_CAR + (size_t)2 * NSUB * 1024 * 4;
constexpr size_t WS_STATS = WS_Y + (size_t)S_ * D_ * 2;
constexpr size_t WS_BAR = WS_STATS + (size_t)S_ * 32 * 2 * 4;
constexpr size_t WS_END = WS_BAR + 16384;
constexpr int LDS_BYTES = 147456;

struct Args {
    const float *x, *w_in, *conv_w, *conv_b, *wa_f, *ba_f, *wx_f, *bx_f, *lam_f, *wa_b, *ba_b, *wx_b, *bx_b, *lam_b, *sc_w, *g_lru, *g_sc, *w_out, *ln_g, *ln_b;
    float* out; unsigned char* ws; int lo, hi;
};

__device__ __forceinline__ unsigned pk_bf16(float lo, float hi) { unsigned r; asm("v_cvt_pk_bf16_f32 %0, %1, %2" : "=v"(r) : "v"(lo), "v"(hi)); return r; }
__device__ __forceinline__ u16 f2bf(float f) { return (u16)(pk_bf16(f, 0.f) & 0xffffu); }
__device__ __forceinline__ float bf2f(unsigned h) { return __uint_as_float(h << 16); }
__device__ __forceinline__ float bflo(unsigned w) { return __uint_as_float(w << 16); }
__device__ __forceinline__ float bfhi(unsigned w) { return __uint_as_float(w & 0xffff0000u); }
__device__ __forceinline__ float sigm(float z) { return __builtin_amdgcn_rcpf(1.0f + __builtin_amdgcn_exp2f(-LOG2E_ * z)); }
__device__ __forceinline__ void wave_lds_sync() { asm volatile("s_waitcnt lgkmcnt(0)" ::: "memory"); }


#define XB_TMO      128
#define XB_XCNT(j)  (256  + 64 * (j))
#define XB_XSUB(j)  (1280 + 64 * (j))
#define XB_XGEN(j)  (2304 + 64 * (j))
#define XB_TOP      3328
#define XB_TOPGEN   3392
#define XCD_BAR_WORDS 3456
#define XB_SPIN_CAP (1u << 18)
__device__ __forceinline__ unsigned xb_ld(unsigned* p)              { return __hip_atomic_load(p, __ATOMIC_RELAXED, __HIP_MEMORY_SCOPE_AGENT); }
__device__ __forceinline__ unsigned xb_add(unsigned* p, unsigned v) { return __hip_atomic_fetch_add(p, v, __ATOMIC_RELAXED, __HIP_MEMORY_SCOPE_AGENT); }
__device__ __forceinline__ unsigned xb_xcc_id() { return (unsigned)__builtin_amdgcn_s_getreg((3 << 11) | 20) & 0xFu; }
#define XB_SPIN(cond, bar) do { unsigned _sp = 0; while (cond) { __builtin_amdgcn_s_sleep(1); \
    if ((++_sp & 255u) == 0u) { if (xb_ld(&(bar)[XB_TMO])) break; if (_sp > XB_SPIN_CAP) { atomicAdd(&(bar)[XB_TMO], 1u); break; } } } } while (0)
struct XcdBarrier { unsigned* bar; unsigned x; volatile LAS unsigned* st; };
__device__ __forceinline__ XcdBarrier xcd_barrier_post(unsigned* bar, volatile LAS unsigned* st) {
    XcdBarrier b; b.bar = bar; b.x = xb_xcc_id(); b.st = st;
    if (threadIdx.x == 0) (void)xb_add(&bar[XB_XCNT(b.x)], 1u);
    return b;
}
__device__ __forceinline__ void xcd_barrier_complete(unsigned* bar, unsigned x, unsigned& nloc, unsigned& nx) {
    const unsigned G = gridDim.x * gridDim.y * gridDim.z;
    unsigned sum, cnt, mine, sp = 0u;
    for (;;) {
        sum = 0u; cnt = 0u; mine = 0u;
#pragma unroll
        for (unsigned j = 0; j < 16; ++j) { const unsigned c = xb_ld(&bar[XB_XCNT(j)]); sum += c; cnt += (c > 0u) ? 1u : 0u; mine = (j == x) ? c : mine; }
        if (sum == G) break;
        __builtin_amdgcn_s_sleep(1);
        if ((++sp & 255u) == 0u) { if (xb_ld(&bar[XB_TMO])) break; if (sp > XB_SPIN_CAP) { atomicAdd(&bar[XB_TMO], 1u); break; } }
    }
    nloc = mine > 0u ? mine : 1u; nx = cnt > 0u ? cnt : 1u;
}
__device__ __forceinline__ void xcd_barrier(const XcdBarrier& b) {
    asm volatile("s_waitcnt vmcnt(0)" ::: "memory");
    __syncthreads();
    if (threadIdx.x == 0) {
        unsigned* bar = b.bar;
        __builtin_amdgcn_s_waitcnt(0);
        unsigned nloc = b.st[0], nx = b.st[1];
        if (nloc == 0u) { xcd_barrier_complete(bar, b.x, nloc, nx); b.st[0] = nloc; b.st[1] = nx; }
        const unsigned old = xb_add(&bar[XB_XSUB(b.x)], 1u);
        const unsigned gen = old / nloc;
        if (old + 1u == (gen + 1u) * nloc) {
            __builtin_amdgcn_fence(__ATOMIC_RELEASE, "agent");
            asm volatile("s_waitcnt vmcnt(0)" ::: "memory");
            const unsigned og = xb_add(&bar[XB_TOP], 1u);
            const unsigned tg = og / nx;
            if (og + 1u == (tg + 1u) * nx) xb_add(&bar[XB_TOPGEN], 1u);
            else XB_SPIN(xb_ld(&bar[XB_TOPGEN]) == tg, bar);
            __builtin_amdgcn_fence(__ATOMIC_ACQUIRE, "agent");
            xb_add(&bar[XB_XGEN(b.x)], 1u);
            asm volatile("s_waitcnt vmcnt(0)" ::: "memory");
        } else {
            XB_SPIN(xb_ld(&bar[XB_XGEN(b.x)]) == gen, bar);
            __builtin_amdgcn_fence(__ATOMIC_ACQUIRE, "agent");
            asm volatile("s_waitcnt vmcnt(0)" ::: "memory");
        }
    }
    __syncthreads();
}

__device__ __forceinline__ void phase0(const Args& a, LAS unsigned char* lds) {
    const int tid = threadIdx.x; const size_t gt = (size_t)blockIdx.x * 512 + tid, GT = (size_t)gridDim.x * 512;
    {
        const f32x4* x4 = (const f32x4*)a.x; u32x4* xb = (u32x4*)(a.ws + WS_XB); const size_t n8 = (size_t)S_ * D_ / 8;
        for (size_t i = gt; i < n8; i += GT) { const f32x4 p = x4[2 * i], q = x4[2 * i + 1]; u32x4 w; w.x = pk_bf16(p[0], p[1]); w.y = pk_bf16(p[2], p[3]); w.z = pk_bf16(q[0], q[1]); w.w = pk_bf16(q[2], q[3]); xb[i] = w; }
    }
    {
        LAS float* tile = (LAS float*)lds;
        for (int ti = blockIdx.x; ti < 3072 + 1024; ti += gridDim.x) {
            const float* src; u16* dst; int N, kt, nt;
            if (ti < 3072) { src = a.w_in; dst = (u16*)(a.ws + WS_WINT); N = PC_; kt = ti / 96; nt = ti % 96; }
            else { const int v = ti - 3072; src = a.w_out; dst = (u16*)(a.ws + WS_WOUTT); N = D_; kt = v / 32; nt = v % 32; }
#pragma unroll
            for (int it = 0; it < 2; ++it) { const int r = it * 32 + (tid >> 4), c4 = (tid & 15) * 4; const f32x4 v = *(const f32x4*)(src + (size_t)(kt * 64 + r) * N + nt * 64 + c4);
                tile[r * 65 + c4 + 0] = v[0]; tile[r * 65 + c4 + 1] = v[1]; tile[r * 65 + c4 + 2] = v[2]; tile[r * 65 + c4 + 3] = v[3]; }
            __syncthreads();
            { const int nn = tid >> 3, k8 = (tid & 7) * 8; float e[8];
#pragma unroll
              for (int j = 0; j < 8; ++j) e[j] = tile[(k8 + j) * 65 + nn];
              u32x4 w; w.x = pk_bf16(e[0], e[1]); w.y = pk_bf16(e[2], e[3]); w.z = pk_bf16(e[4], e[5]); w.w = pk_bf16(e[6], e[7]);
              *(u32x4*)(dst + (size_t)(nt * 64 + nn) * D_ + kt * 64 + k8) = w; }
            __syncthreads();
        }
    }
    {
        u16* gw = (u16*)(a.ws + WS_GW);
        for (size_t idx = gt; idx < (size_t)16 * 4 * 64 * 64; idx += GT) { const int i = (int)(idx & 63), j = (int)((idx >> 6) & 63), mat = (int)((idx >> 12) & 3), hd = (int)(idx >> 14);
            const float* m = mat == 0 ? a.wa_f : mat == 1 ? a.wx_f : mat == 2 ? a.wa_b : a.wx_b; gw[idx] = f2bf(m[hd * 4096 + i * 64 + j]); }
        float* kk = (float*)(a.ws + WS_K);
        for (size_t idx = gt; idx < 2048; idx += GT) { const float lam = (idx < 1024 ? a.lam_f : a.lam_b)[idx & 1023]; const float xx = -lam;
            const float sp = fmaxf(xx, 0.f) + log1pf(expf(-fabsf(xx))); kk[idx] = -8.0f * sp * LOG2E_; }
    }
}

__device__ __forceinline__ void gate_math(float zr, float zi, float k, float u, float& a, float& bv) {
    const float r = sigm(zr), ig = sigm(zi);
    const float l2a = k * r;
    a = __builtin_amdgcn_exp2f(l2a);
    const float x = l2a * (2.0f * LN2_);
    const float p = 1.0f + x * (0.5f + x * (0.16666667f + x * (0.041666668f + x * (0.0083333338f + x * 0.0013888889f))));
    const float m2 = (x > -0.3f) ? (-x * p) : (1.0f - a * a);
    bv = __builtin_amdgcn_sqrtf(m2) * ig * u;
}

template <bool FINAL>
__device__ __forceinline__ void scan_phase(const Args& a, LAS unsigned char* lds) {
    const int tid = threadIdx.x, lane = tid & 63, wave = tid >> 6, hh = lane >> 5, n = lane & 31;
    constexpr int XS = 72;
    constexpr int YS = 1032;
    LAS u16* xt = (LAS u16*)(lds + wave * 9728);
    LAS u16* ut = (LAS u16*)(lds + wave * 9728 + 5120);
    LAS u16* ytl = (LAS u16*)(lds + 77824);
    LAS float* part_l = (LAS float*)(lds + 77824 + 66048);
    LAS float* part_s = part_l + 256;
    LAS float* scl = part_s + 64;
    const u16* proj = (const u16*)(a.ws + WS_PROJ);
    const u16* gw = (const u16*)(a.ws + WS_GW);
    const float* kk = (const float*)(a.ws + WS_K);
    float* sum = (float*)(a.ws + WS_SUM);
    const float* car = (const float*)(a.ws + WS_CAR);
    u16* Y = (u16*)(a.ws + WS_Y);
    constexpr size_t PL = (size_t)NSUB * 1024;

    for (int j = blockIdx.x; j < S_ / 32; j += gridDim.x) {
        const int t0 = j * 32;
        float ssq[16];
#pragma unroll
        for (int q = 0; q < 16; ++q) ssq[q] = 0.f;
#pragma unroll 1
        for (int h2 = 0; h2 < 2; ++h2) {
            const int hd = wave * 2 + h2;
#pragma unroll
            for (int it = 0; it < 5; ++it) { const int row = it * 8 + (lane >> 3), c8 = lane & 7;
                if (row < 35) { const int t = t0 - 2 + row; u32x4 v = (u32x4){0u, 0u, 0u, 0u};
                    if (t >= 0 && t < S_) v = *(const u32x4*)(proj + (size_t)t * PC_ + hd * 64 + c8 * 8);
                    *(LAS u32x4*)(xt + row * XS + c8 * 8) = v; } }
            wave_lds_sync();
#pragma unroll 1
            for (int nt = 0; nt < 2; ++nt) { const int c = hd * 64 + nt * 32 + n;
                const float w0 = a.conv_w[c], w1 = a.conv_w[1024 + c], w2 = a.conv_w[2048 + c], w3 = a.conv_w[3072 + c], cb = a.conv_b[c];
                float xv[19];
#pragma unroll
                for (int r = 0; r < 19; ++r) xv[r] = bf2f(xt[(16 * hh + r) * XS + nt * 32 + n]);
#pragma unroll
                for (int q = 0; q < 16; ++q) { const float uu = cb + w0 * xv[q] + w1 * xv[q + 1] + w2 * xv[q + 2] + w3 * xv[q + 3]; ut[(16 * hh + q) * XS + nt * 32 + n] = f2bf(uu); } }
            wave_lds_sync();
            bf16x8 Af[4];
            { const int r = lane & 31, tau = 16 * ((r >> 2) & 1) + 4 * (r >> 3) + (r & 3);
#pragma unroll
              for (int k4 = 0; k4 < 4; ++k4) Af[k4] = *(const LAS bf16x8*)(ut + tau * XS + k4 * 16 + 8 * hh); }
#pragma unroll 1
            for (int nt = 0; nt < 2; ++nt) {
                const int c = hd * 64 + nt * 32 + n;
                float uq[16];
#pragma unroll
                for (int q = 0; q < 16; ++q) uq[q] = bf2f(ut[(16 * hh + q) * XS + nt * 32 + n]);
                const size_t sidx = (size_t)(2 * j + hh) * 1024 + c;
                float hs[16];
#pragma unroll
                for (int dir = 0; dir < 2; ++dir) {
                    f32x16 accr, acci;
#pragma unroll
                    for (int q = 0; q < 16; ++q) { accr[q] = 0.f; acci[q] = 0.f; }
                    const u16* gwr = gw + (size_t)((hd * 4 + 2 * dir) * 64 + nt * 32 + n) * 64 + 8 * hh;
#pragma unroll
                    for (int k4 = 0; k4 < 4; ++k4) { const bf16x8 Br = *(const bf16x8*)(gwr + k4 * 16), Bi = *(const bf16x8*)(gwr + 4096 + k4 * 16);
                        accr = __builtin_amdgcn_mfma_f32_32x32x16_bf16(Af[k4], Br, accr, 0, 0, 0); acci = __builtin_amdgcn_mfma_f32_32x32x16_bf16(Af[k4], Bi, acci, 0, 0, 0); }
                    const float br = (dir ? a.ba_b : a.ba_f)[c], bi = (dir ? a.bx_b : a.bx_f)[c], kd = kk[dir * 1024 + c];
                    float av[16], bv[16];
#pragma unroll
                    for (int q = 0; q < 16; ++q) gate_math(accr[q] + br, acci[q] + bi, kd, uq[q], av[q], bv[q]);
                    if (!FINAL) {
                        float Ac = 1.f, Hc = 0.f;
#pragma unroll
                        for (int q = 0; q < 16; ++q) { const int qq = dir ? 15 - q : q; Ac *= av[qq]; Hc = av[qq] * Hc + bv[qq]; }
                        sum[(size_t)(2 * dir) * PL + sidx] = Ac; sum[(size_t)(2 * dir + 1) * PL + sidx] = Hc;
                    } else {
                        float h = car[(size_t)dir * PL + sidx];
#pragma unroll
                        for (int q = 0; q < 16; ++q) { const int qq = dir ? 15 - q : q; h = av[qq] * h + bv[qq]; if (dir == 0) hs[qq] = h; else hs[qq] += h; }
                    }
                }
                if (FINAL) {
#pragma unroll
                    for (int q = 0; q < 16; ++q) { const float g = bf2f(proj[(size_t)(t0 + 16 * hh + q) * PC_ + 1024 + c]); const float v = hs[q] * g * sigm(g); ytl[(16 * hh + q) * YS + c] = f2bf(v); ssq[q] += v * v; }
                }
            }
            wave_lds_sync();
        }
        if (FINAL) {
            const int cgp = tid & 127, c0 = cgp * 8, rq = tid >> 7;
            float w0[8], w1[8], w2[8];
#pragma unroll
            for (int e = 0; e < 8; ++e) { w0[e] = a.sc_w[c0 + e]; w1[e] = a.sc_w[1024 + c0 + e]; w2[e] = a.sc_w[2048 + c0 + e]; }
            float prev[8], cur[8], nxt[8], ss[8]; unsigned qp[8][4];
            auto loadp = [&](int t, float (&p)[8]) {
                if (t >= 0 && t < S_) { const u32x4 cv = *(const u32x4*)(proj + (size_t)t * PC_ + 3072 + c0), hv = *(const u32x4*)(proj + (size_t)t * PC_ + 4096 + c0);
                    p[0] = bflo(cv.x) * bflo(hv.x); p[1] = bfhi(cv.x) * bfhi(hv.x); p[2] = bflo(cv.y) * bflo(hv.y); p[3] = bfhi(cv.y) * bfhi(hv.y);
                    p[4] = bflo(cv.z) * bflo(hv.z); p[5] = bfhi(cv.z) * bfhi(hv.z); p[6] = bflo(cv.w) * bflo(hv.w); p[7] = bfhi(cv.w) * bfhi(hv.w); }
                else {
#pragma unroll
                    for (int e = 0; e < 8; ++e) p[e] = 0.f; } };
            const int tb = t0 + rq * 8;
            loadp(tb - 1, prev); loadp(tb, cur);
#pragma unroll
            for (int r = 0; r < 8; ++r) { const int t = tb + r; loadp(t + 1, nxt);
                const u32x4 bv4 = *(const u32x4*)(proj + (size_t)t * PC_ + 2048 + c0), gv4 = *(const u32x4*)(proj + (size_t)t * PC_ + 5120 + c0);
                float bvv[8] = {bflo(bv4.x), bfhi(bv4.x), bflo(bv4.y), bfhi(bv4.y), bflo(bv4.z), bfhi(bv4.z), bflo(bv4.w), bfhi(bv4.w)};
                float gvv[8] = {bflo(gv4.x), bfhi(gv4.x), bflo(gv4.y), bfhi(gv4.y), bflo(gv4.z), bfhi(gv4.z), bflo(gv4.w), bfhi(gv4.w)};
                float s = 0.f, qq[8];
#pragma unroll
                for (int e = 0; e < 8; ++e) { const float v = w0[e] * prev[e] + w1[e] * cur[e] + w2[e] * nxt[e]; qq[e] = bvv[e] * v * gvv[e] * sigm(gvv[e]); s += qq[e] * qq[e]; prev[e] = cur[e]; cur[e] = nxt[e]; }
#pragma unroll
                for (int e = 0; e < 4; ++e) qp[r][e] = pk_bf16(qq[2 * e], qq[2 * e + 1]);
                ss[r] = s; }
            {   const bool b4 = (n & 16) != 0, b3 = (n & 8) != 0, b2 = (n & 4) != 0, b1 = (n & 2) != 0;
                float v8[8], v4[4], v2[2], v1;
#pragma unroll
                for (int i = 0; i < 8; ++i) { const float snd = b4 ? ssq[i] : ssq[i + 8]; const float rcv = __shfl_xor(snd, 16); v8[i] = (b4 ? ssq[i + 8] : ssq[i]) + rcv; }
#pragma unroll
                for (int i = 0; i < 4; ++i) { const float snd = b3 ? v8[i] : v8[i + 4]; const float rcv = __shfl_xor(snd, 8); v4[i] = (b3 ? v8[i + 4] : v8[i]) + rcv; }
#pragma unroll
                for (int i = 0; i < 2; ++i) { const float snd = b2 ? v4[i] : v4[i + 2]; const float rcv = __shfl_xor(snd, 4); v2[i] = (b2 ? v4[i + 2] : v4[i]) + rcv; }
                { const float snd = b1 ? v2[0] : v2[1]; const float rcv = __shfl_xor(snd, 2); v1 = (b1 ? v2[1] : v2[0]) + rcv; }
                v1 += __shfl_xor(v1, 1);
                if ((n & 1) == 0) part_l[wave * 32 + 16 * hh + (n >> 1)] = v1; }
            {   const bool b5 = (lane & 32) != 0, b4 = (lane & 16) != 0, b3 = (lane & 8) != 0;
                float v4[4], v2[2], v1;
#pragma unroll
                for (int i = 0; i < 4; ++i) { const float snd = b5 ? ss[i] : ss[i + 4]; const float rcv = __shfl_xor(snd, 32); v4[i] = (b5 ? ss[i + 4] : ss[i]) + rcv; }
#pragma unroll
                for (int i = 0; i < 2; ++i) { const float snd = b4 ? v4[i] : v4[i + 2]; const float rcv = __shfl_xor(snd, 16); v2[i] = (b4 ? v4[i + 2] : v4[i]) + rcv; }
                { const float snd = b3 ? v2[0] : v2[1]; const float rcv = __shfl_xor(snd, 8); v1 = (b3 ? v2[1] : v2[0]) + rcv; }
                v1 += __shfl_xor(v1, 4); v1 += __shfl_xor(v1, 2); v1 += __shfl_xor(v1, 1);
                if ((lane & 7) == 0) part_s[wave * 8 + (lane >> 3)] = v1; }
            __syncthreads();
            if (tid < 32) { float s = 0.f;
#pragma unroll
                for (int w = 0; w < 8; ++w) s += part_l[w * 32 + tid];
                scl[tid] = __builtin_amdgcn_rsqf(s * (1.0f / 1024.0f) + 1e-6f); }
            else if (tid < 64) { const int t = tid - 32, g = t >> 3, r = t & 7; const float s = part_s[(2 * g) * 8 + r] + part_s[(2 * g + 1) * 8 + r];
                scl[32 + t] = __builtin_amdgcn_rsqf(s * (1.0f / 1024.0f) + 1e-6f); }
            __syncthreads();
            { float gl[8], gs[8];
#pragma unroll
              for (int e = 0; e < 8; ++e) { gl[e] = a.g_lru[c0 + e]; gs[e] = a.g_sc[c0 + e]; }
#pragma unroll
              for (int r = 0; r < 8; ++r) { const float sl = scl[rq * 8 + r], s = scl[32 + rq * 8 + r];
                  const u32x4 hv = *(const LAS u32x4*)(ytl + (rq * 8 + r) * YS + c0); u32x4 w;
                  w.x = pk_bf16(bflo(hv.x) * sl * gl[0], bfhi(hv.x) * sl * gl[1]); w.y = pk_bf16(bflo(hv.y) * sl * gl[2], bfhi(hv.y) * sl * gl[3]);
                  w.z = pk_bf16(bflo(hv.z) * sl * gl[4], bfhi(hv.z) * sl * gl[5]); w.w = pk_bf16(bflo(hv.w) * sl * gl[6], bfhi(hv.w) * sl * gl[7]);
                  *(u32x4*)(Y + (size_t)(tb + r) * D_ + c0) = w;
                  w.x = pk_bf16(bflo(qp[r][0]) * s * gs[0], bfhi(qp[r][0]) * s * gs[1]); w.y = pk_bf16(bflo(qp[r][1]) * s * gs[2], bfhi(qp[r][1]) * s * gs[3]);
                  w.z = pk_bf16(bflo(qp[r][2]) * s * gs[4], bfhi(qp[r][2]) * s * gs[5]); w.w = pk_bf16(bflo(qp[r][3]) * s * gs[6], bfhi(qp[r][3]) * s * gs[7]);
                  *(u32x4*)(Y + (size_t)(tb + r) * D_ + 1024 + c0) = w; } }
            __syncthreads();
        }
    }
}

template <bool REV>
__device__ __forceinline__ void carry_unit(const float* SA, const float* SH, float* CO, int c, int g, int cl, LAS float* gA, LAS float* gH) {
    float A[32], H[32];
#pragma unroll
    for (int s = 0; s < 32; ++s) { const size_t k = (size_t)(g * 32 + s); A[s] = SA[k * 1024 + c]; H[s] = SH[k * 1024 + c]; }
    float Ag = 1.f, Hg = 0.f;
#pragma unroll
    for (int s = 0; s < 32; ++s) { const int sr = REV ? 31 - s : s; Ag *= A[sr]; Hg = A[sr] * Hg + H[sr]; }
    gA[g * 16 + cl] = Ag; gH[g * 16 + cl] = Hg;
    __syncthreads();
    float h = 0.f;
    if (!REV) { for (int gg = 0; gg < g; ++gg) h = gA[gg * 16 + cl] * h + gH[gg * 16 + cl]; }
    else { for (int gg = 31; gg > g; --gg) h = gA[gg * 16 + cl] * h + gH[gg * 16 + cl]; }
#pragma unroll
    for (int s = 0; s < 32; ++s) { const int sr = REV ? 31 - s : s; CO[(size_t)(g * 32 + sr) * 1024 + c] = h; h = A[sr] * h + H[sr]; }
    __syncthreads();
}
__device__ __forceinline__ void carry_phase(const Args& a, LAS unsigned char* lds) {
    const int tid = threadIdx.x, cl = tid & 15, g = tid >> 4;
    LAS float* gA = (LAS float*)lds; LAS float* gH = gA + 512;
    const float* sum = (const float*)(a.ws + WS_SUM); float* car = (float*)(a.ws + WS_CAR);
    constexpr size_t PL = (size_t)NSUB * 1024;
    for (int bu = blockIdx.x; bu < 128; bu += gridDim.x) {
        const int dir = bu >> 6, c = (bu & 63) * 16 + cl;
        if (dir == 0) carry_unit<false>(sum, sum + PL, car, c, g, cl, gA, gH);
        else carry_unit<true>(sum + 2 * PL, sum + 3 * PL, car + PL, c, g, cl, gA, gH);
    }
}

__device__ __forceinline__ void ln_phase(const Args& a) {
    const int tid = threadIdx.x, lane = tid & 63, wave = tid >> 6;
    const f32x2* stats = (const f32x2*)(a.ws + WS_STATS);
    for (int row = blockIdx.x * 8 + wave; row < S_; row += gridDim.x * 8) {
        f32x2 st = (f32x2){0.f, 0.f};
        if (lane < 32) st = stats[(size_t)row * 32 + lane];
        float s = st.x, q = st.y;
#pragma unroll
        for (int o = 32; o >= 1; o >>= 1) { s += __shfl_xor(s, o); q += __shfl_xor(q, o); }
        const float mean = s * (1.0f / 2048.0f), var = fmaxf(q * (1.0f / 2048.0f) - mean * mean, 0.f), rstd = __builtin_amdgcn_rsqf(var + 1e-5f);
        float* zr = a.out + (size_t)row * D_;
#pragma unroll
        for (int i = 0; i < 8; ++i) { const int col = i * 256 + lane * 4; const f32x4 z = *(const f32x4*)(zr + col), g = *(const f32x4*)(a.ln_g + col), b = *(const f32x4*)(a.ln_b + col);
            *(f32x4*)(zr + col) = (z - mean) * rstd * g + b; }
    }
}

__global__ void __launch_bounds__(512, 2) fwd_kernel(Args a) {
    extern __shared__ __attribute__((aligned(16))) unsigned char shm[];
    LAS unsigned char* lds = (LAS unsigned char*)shm;
    cg::grid_group grid = cg::this_grid();
    volatile LAS unsigned* xst = (volatile LAS unsigned*)(lds + LDS_BYTES - 16);
    if (threadIdx.x < 4) xst[threadIdx.x] = 0u;
    __syncthreads();
    XcdBarrier xbar; xbar.bar = (unsigned*)(a.ws + WS_BAR); xbar.x = 0; xbar.st = xst;
    if (a.hi - a.lo > 1) xbar = xcd_barrier_post((unsigned*)(a.ws + WS_BAR), xst);
    if (a.hi > 7) grid.sync();
#define IN(k) (a.lo <= (k) && (k) < a.hi)
#ifndef PROBE_DUP
#define PROBE_DUP -1
#endif
#define REP(k) for (int rep_ = 0; rep_ < ((k) == PROBE_DUP ? 2 : 1); ++rep_)
#define SEAM(k) do { if (IN(k) && IN((k) + 1)) xcd_barrier(xbar); } while (0)
#ifndef SKIP0
    if (IN(0)) REP(0) { phase0(a, lds); if (PROBE_DUP == 0) __syncthreads(); }
#endif
    SEAM(0);
#ifndef SKIP1
    if (IN(1)) REP(1) { pg8::Gemm g{(const pg8::bf16_t*)(a.ws + WS_XB), (const pg8::bf16_t*)(a.ws + WS_WINT), S_, PC_, D_}; pg8::StaticOrder S; S.init(S_, PC_, (int)gridDim.x, (int)blockIdx.x);
        pg8::EpiBf16<0> E{(pg8::bf16_t*)(a.ws + WS_PROJ), PC_, nullptr, 0, 0};
        pg8::gemm_phase<pg8::EpiBf16<0>, pg8::StaticOrder, false>(lds, g, S, E, nullptr); }
#endif
    SEAM(1);
#ifndef SKIP2
    if (IN(2)) REP(2) { scan_phase<false>(a, lds); if (PROBE_DUP == 2) __syncthreads(); }
#endif
    SEAM(2);
#ifndef SKIP3
    if (IN(3)) carry_phase(a, lds);
#endif
    SEAM(3);
#ifndef SKIP4
    if (IN(4)) REP(4) { scan_phase<true>(a, lds); }
#endif
    SEAM(4);
#ifndef SKIP5
    if (IN(5)) REP(5) { pg8::Gemm g{(const pg8::bf16_t*)(a.ws + WS_Y), (const pg8::bf16_t*)(a.ws + WS_WOUTT), S_, D_, D_}; pg8::StaticOrder S; S.init(S_, D_, (int)gridDim.x, (int)blockIdx.x);
        pg8::EpiZ E{a.out, a.x, (float*)(a.ws + WS_STATS), D_, ALPHA_};
        pg8::gemm_phase<pg8::EpiZ, pg8::StaticOrder, false>(lds, g, S, E, nullptr); }
#endif
    SEAM(5);
#ifndef SKIP6
    if (IN(6)) ln_phase(a);
#endif
#undef IN
#undef SEAM
}

extern "C" void kernel_launch(void* const* d_in, const int* in_sizes, int n_in, void* d_out, int out_size, void* d_ws, size_t ws_size, hipStream_t stream) {
    static int grid = 0;
    if (grid == 0) {
        if (n_in != 20 || in_sizes[0] != S_ * D_ || out_size != S_ * D_ || ws_size < WS_END) { fprintf(stderr, "kernel_launch: unexpected shapes (n_in %d, in0 %d, out %d, ws %zu < %zu)\n", n_in, n_in > 0 ? in_sizes[0] : -1, out_size, ws_size, (size_t)WS_END); grid = -1; return; }
        int dev = 0, cus = 0, per_cu = 0;
        if (hipGetDevice(&dev) != hipSuccess || hipDeviceGetAttribute(&cus, hipDeviceAttributeMultiprocessorCount, dev) != hipSuccess) { grid = -1; return; }
        if (hipFuncSetAttribute((const void*)fwd_kernel, hipFuncAttributeMaxDynamicSharedMemorySize, LDS_BYTES) != hipSuccess) { fprintf(stderr, "kernel_launch: hipFuncSetAttribute failed\n"); grid = -1; return; }
        if (hipOccupancyMaxActiveBlocksPerMultiprocessor(&per_cu, (const void*)fwd_kernel, 512, LDS_BYTES) != hipSuccess || per_cu < 1) { fprintf(stderr, "kernel_launch: occupancy query says %d blocks per CU\n", per_cu); per_cu = 1; (void)hipGetLastError(); }
        grid = cus * per_cu;
    }
    if (grid < 0) return;
    Args a{};
    const float** ap = (const float**)&a;
    for (int i = 0; i < 20; ++i) ap[i] = (const float*)d_in[i];
    a.out = (float*)d_out; a.ws = (unsigned char*)d_ws;
#if MK_LAUNCHES == 1
    a.lo = 0; a.hi = 7;
    if (hipMemsetAsync((unsigned char*)d_ws + WS_BAR, 0, 16384, stream) != hipSuccess) { fprintf(stderr, "kernel_launch: memset of the barrier words failed\n"); return; }
    void* args[] = {&a};
    hipError_t e = hipLaunchCooperativeKernel((const void*)fwd_kernel, dim3(grid), dim3(512), args, LDS_BYTES, stream);
    if (e != hipSuccess) fprintf(stderr, "cooperative launch failed: %s (grid %d)\n", hipGetErrorString(e), grid);
#else
    for (int p = 0; p < 7; ++p) { a.lo = p; a.hi = p + 1; hipLaunchKernelGGL(fwd_kernel, dim3(grid), dim3(512), LDS_BYTES, stream, a); }
#endif
}
```
